# Optimizing an MI355X kernel written in HIP

```python
import math
import jax, jax.numpy as jnp
from jax import lax
import numpy as np

D_MODEL = 1024
BATCH = 32
SEQ = 2048
DEPTH = 2

HEAD_DIM = 128
HEADS_PER_GROUP = 4
ATTN_PATTERNS = ((128, 1), (512, 4), (2048, 16))
N_ATTN_GROUPS = len(ATTN_PATTERNS)
ATTN_WIDTH = N_ATTN_GROUPS * HEADS_PER_GROUP * HEAD_DIM
ATTN_OUT_WIDTH = HEADS_PER_GROUP * HEAD_DIM
ROPE_DIM = HEAD_DIM // 4
ROPE_THETA = 500000.0
BLOCK = 128
NEG_INF = -1e30
POOL_WINDOWS = (2, 4, 8, 16)
POOL_GROUP_WIDTH = D_MODEL // 4
POOL_WIDTH = len(POOL_WINDOWS) * POOL_GROUP_WIDTH
IN_WIDTH = 3 * ATTN_WIDTH + POOL_WIDTH + 2 * D_MODEL
D_FF = 2816
CONV_WIDTH = 3
PLE_DIM = 256
RMS_EPS = 1e-6

kernel_name = 'hybrid_dilated_attn_pool_gated_merge'


def rmsnorm(x, g):
    x32 = x.astype(jnp.float32)
    y = x32 * lax.rsqrt(jnp.mean(x32 * x32, axis=-1, keepdims=True) + RMS_EPS)
    return (y * g.astype(jnp.float32)).astype(x.dtype)


def partial_rotary(t, cos, sin):
    half = ROPE_DIM // 2
    t1 = t[..., :half].astype(jnp.float32)
    t2 = t[..., half:ROPE_DIM].astype(jnp.float32)
    c = cos[:, None, None, :]
    s = sin[:, None, None, :]
    rot = jnp.concatenate([t1 * c - t2 * s, t2 * c + t1 * s], axis=-1).astype(t.dtype)
    return jnp.concatenate([rot, t[..., ROPE_DIM:]], axis=-1)


def dilated_window_attention(q, k, v, window, dilation):
    B, S, H, hd = q.shape
    span = BLOCK * dilation
    s_pad = -(-S // span) * span
    L = s_pad // dilation
    nb = L // BLOCK
    w_sub = window // dilation

    def to_blocks(t):
        t = jnp.pad(t, ((0, 0), (0, s_pad - S), (0, 0), (0, 0)))
        t = t.reshape(B, L, dilation, H, hd).transpose(0, 2, 1, 3, 4)
        return t.reshape(B, dilation, nb, BLOCK, H, hd)

    def with_prev(t):
        prev = jnp.pad(t, ((0, 0), (0, 0), (1, 0), (0, 0), (0, 0), (0, 0)))[:, :, :-1]
        return jnp.concatenate([prev, t], axis=3)

    qb = to_blocks(q)
    kk = with_prev(to_blocks(k))
    vv = with_prev(to_blocks(v))
    scores = jnp.einsum('brnqhd,brnkhd->brnhqk', qb, kk,
                        preferred_element_type=jnp.float32) * (hd ** -0.5)
    qi = jnp.arange(BLOCK)[:, None]
    ki = jnp.arange(2 * BLOCK)[None, :]
    diff = BLOCK + qi - ki
    band = (diff >= 0) & (diff <= w_sub)
    blk = jnp.arange(nb)[:, None, None]
    mask = band[None] & ((blk > 0) | (ki[None] >= BLOCK))
    scores = jnp.where(mask[None, None, :, None], scores, NEG_INF)
    lse = jax.nn.logsumexp(scores, axis=-1)
    probs = jnp.exp(scores - lse[..., None])
    out = jnp.einsum('brnhqk,brnkhd->brnqhd', probs.astype(v.dtype), vv,
                     preferred_element_type=jnp.float32)
    out = out.reshape(B, dilation, L, H, hd).transpose(0, 2, 1, 3, 4)
    out = out.reshape(B, s_pad, H, hd)[:, :S]
    lse = lse.transpose(0, 1, 2, 4, 3).reshape(B, dilation, L, H).transpose(0, 2, 1, 3)
    lse = lse.reshape(B, s_pad, H)[:, :S]
    return out, lse


def multiscale_pool_mixer(u, pool_w, pool_scale):
    B, S, _ = u.shape
    u32 = u.astype(jnp.float32)
    csum = jnp.cumsum(u32, axis=1)
    t = jnp.arange(S)
    groups = []
    for g, w in enumerate(POOL_WINDOWS):
        sl = slice(g * POOL_GROUP_WIDTH, (g + 1) * POOL_GROUP_WIDTH)
        cg = csum[..., sl]
        shifted = jnp.pad(cg, ((0, 0), (w, 0), (0, 0)))[:, :S]
        count = jnp.minimum(t + 1, w).astype(jnp.float32)
        groups.append((cg - shifted) / count[None, :, None] - u32[..., sl])
    pooled = jnp.stack(groups, axis=2).astype(u.dtype)
    mixed = jnp.einsum('bsgc,gcd->bsgd', pooled, pool_w).reshape(B, S, POOL_WIDTH)
    return mixed * pool_scale


def conv_gated_mlp(h, w_up, conv_w, conv_b, w_down):
    S = h.shape[1]
    u = h @ w_up
    y = conv_b
    for tap in range(CONV_WIDTH):
        shift = CONV_WIDTH - 1 - tap
        y = y + conv_w[tap] * jnp.pad(u, ((0, 0), (shift, 0), (0, 0)))[:, :S]
    gate, val = jnp.split(y, 2, axis=-1)
    return (jax.nn.silu(gate) * val) @ w_down


def setup_inputs(seed: int = 0) -> dict:
    key = jax.random.key(seed)
    ks = jax.random.split(key, 20)
    f32 = jnp.float32

    def nrm(k, shape, fan_in):
        return jax.random.normal(k, shape, f32) * (fan_in ** -0.5)

    def gain(k, shape):
        return 1.0 + 0.02 * jax.random.normal(k, shape, f32)

    return {
        'x': jax.random.normal(ks[0], (BATCH, SEQ, D_MODEL), f32),
        'p': jax.random.normal(ks[1], (DEPTH, BATCH, SEQ, PLE_DIM), f32),
        'g_mix': gain(ks[2], (DEPTH, D_MODEL)),
        'w_in': nrm(ks[3], (DEPTH, D_MODEL, IN_WIDTH), D_MODEL),
        'w_ya': nrm(ks[4], (DEPTH, ATTN_OUT_WIDTH, D_MODEL), ATTN_OUT_WIDTH),
        'w_yb': nrm(ks[5], (DEPTH, POOL_WIDTH, D_MODEL), POOL_WIDTH),
        'pool_w': nrm(ks[6], (DEPTH, len(POOL_WINDOWS), POOL_GROUP_WIDTH, POOL_GROUP_WIDTH), POOL_GROUP_WIDTH),
        'pool_scale': gain(ks[7], (DEPTH, POOL_WIDTH)),
        'w_o': nrm(ks[8], (DEPTH, D_MODEL, D_MODEL), D_MODEL),
        'g_ffn': gain(ks[9], (DEPTH, D_MODEL)),
        'w_up': nrm(ks[10], (DEPTH, D_MODEL, 2 * D_FF), D_MODEL),
        'conv_w': nrm(ks[11], (DEPTH, CONV_WIDTH, 2 * D_FF), CONV_WIDTH),
        'conv_b': 0.01 * jax.random.normal(ks[12], (DEPTH, 2 * D_FF), f32),
        'w_down': nrm(ks[13], (DEPTH, D_FF, D_MODEL), D_FF),
        'g_ple': gain(ks[14], (DEPTH, D_MODEL)),
        'w_ple': nrm(ks[15], (DEPTH, PLE_DIM, D_MODEL), PLE_DIM),
        'w_ple_gate': nrm(ks[16], (DEPTH, D_MODEL, D_MODEL), D_MODEL),
        'g_final': gain(ks[17], (D_MODEL,)),
    }


def reference(x, p, g_mix, w_in, w_ya, w_yb, pool_w, pool_scale, w_o, g_ffn,
              w_up, conv_w, conv_b, w_down, g_ple, w_ple, w_ple_gate, g_final):
    B, S, _ = x.shape
    pos = jnp.arange(S, dtype=jnp.float32)
    inv_freq = jnp.exp(jnp.arange(0, ROPE_DIM, 2, dtype=jnp.float32)
                       * (-math.log(ROPE_THETA) / ROPE_DIM))
    ang = pos[:, None] * inv_freq[None, :]
    cos, sin = jnp.cos(ang), jnp.sin(ang)
    split_at = [ATTN_WIDTH, 2 * ATTN_WIDTH, 3 * ATTN_WIDTH,
                3 * ATTN_WIDTH + POOL_WIDTH, 3 * ATTN_WIDTH + POOL_WIDTH + D_MODEL]
    head_shape = (B, S, N_ATTN_GROUPS, HEADS_PER_GROUP, HEAD_DIM)

    for i in range(DEPTH):
        h = rmsnorm(x, g_mix[i])
        z = h @ w_in[i]
        q, k, v, u_pool, gate_a, gate_b = jnp.split(z, split_at, axis=-1)
        q = partial_rotary(q.reshape(head_shape), cos, sin)
        k = partial_rotary(k.reshape(head_shape), cos, sin)
        v = v.reshape(head_shape)

        outs, lses = [], []
        for g, (window, dilation) in enumerate(ATTN_PATTERNS):
            o_g, lse_g = dilated_window_attention(q[:, :, g], k[:, :, g], v[:, :, g],
                                                  window, dilation)
            outs.append(o_g)
            lses.append(lse_g)
        weights = jax.nn.softmax(jnp.stack(lses, axis=0), axis=0)
        attn = jnp.sum(weights[..., None] * jnp.stack(outs, axis=0), axis=0)
        y_a = attn.reshape(B, S, ATTN_OUT_WIDTH).astype(x.dtype) @ w_ya[i]

        y_b = multiscale_pool_mixer(u_pool, pool_w[i], pool_scale[i]) @ w_yb[i]

        merged = jax.nn.sigmoid(gate_a) * y_a + jax.nn.sigmoid(gate_b) * y_b
        x = x + merged @ w_o[i]

        x = x + conv_gated_mlp(rmsnorm(x, g_ffn[i]), w_up[i], conv_w[i], conv_b[i], w_down[i])

        ple_gate = jax.nn.sigmoid(rmsnorm(x, g_ple[i]) @ w_ple_gate[i])
        x = x + (p[i] @ w_ple[i]) * ple_gate

    return rmsnorm(x, g_final)
```

```cpp
#include <hip/hip_runtime.h>
#include <hip/hip_cooperative_groups.h>
#include <cstdio>
#include <cstdint>
#include <cmath>
namespace cg = cooperative_groups;

namespace pg8 {
#define PG8_LAS __attribute__((address_space(3)))
typedef unsigned short bf16_t;
typedef short bf16x8 __attribute__((ext_vector_type(8)));
typedef float f32x4 __attribute__((ext_vector_type(4)));
typedef unsigned u32x4 __attribute__((ext_vector_type(4)));
constexpr int BM = 256, BK = 64, HALF = 128, HTB = HALF * BK * 2  , STAGE_BYTES = 8 * HTB, NXCD = 8, WGM = 8;

__host__ __device__ __forceinline__ int lds_byte(int r, int c) { const int st = (r >> 4) * 2 + (c >> 5), rr = r & 15, cc = c & 31, ob = rr * 64 + cc * 2; return st * 1024 + (ob ^ (((ob >> 9) & 1) << 5)); }
__host__ __device__ __forceinline__ void stage_rc(int b, int& R, int& C) { const int st = b / 1024, sb = b % 1024, swz = sb ^ (((sb >> 9) & 1) << 5); R = (st >> 1) * 16 + swz / 64; C = (st & 1) * 32 + (swz % 64) / 2; }
__host__ __device__ __forceinline__ int perm32(int rho) { const int n = rho >> 4, i = rho & 15; return 8 * (i >> 2) + 4 * n + (i & 3); }

struct Unit { int pm, pn, ui; };
struct Gemm { const bf16_t* A; const bf16_t* Bt; int M, N, K; };

struct StaticOrder {
    int nM, nN, nwg, G, c, wgm;
    __host__ __device__ void init(int M, int N, int G_, int c_, int wgm_ = WGM) { nM = M / BM; nN = N / BM; nwg = nM * nN; G = G_; c = c_; wgm = wgm_; }
    __host__ __device__ bool next(int i, Unit& u) const {
        const int L = i * G + c; if (L >= nwg) return false;
        int wgid = L; { const int q = nwg / NXCD, r = nwg % NXCD, xcd = wgid % NXCD, off = wgid / NXCD; wgid = (xcd < r ? xcd * (q + 1) : r * (q + 1) + (xcd - r) * q) + off; }
        const int nig = wgm * nN, gid = wgid / nig, fm = gid * wgm, gsz = (nM - fm) < wgm ? (nM - fm) : wgm;
        u.pm = fm + ((wgid % nig) % gsz); u.pn = (wgid % nig) / gsz; u.ui = i; return true;
    }
    __device__ __forceinline__ void a_ready(const Unit&) const {}
    __device__ __forceinline__ void done(const Unit&) const {}
};

__device__ __forceinline__ unsigned cvt_pk_bf16(float lo, float hi) { unsigned r; asm volatile("v_cvt_pk_bf16_f32 %0, %1, %2" : "=v"(r) : "v"(lo), "v"(hi)); return r; }
typedef float f32x2 __attribute__((ext_vector_type(2)));

template <class Epi, class Sched, bool ALIGN_EPI = false, bool SP2 = false>
__device__ __forceinline__ void gemm_phase(PG8_LAS unsigned char* lds, const Gemm g, const Sched& S, const Epi& E, const int tid_in) {
    int tid_ = tid_in; asm volatile("" : "+v"(tid_));
    const int tid = tid_, wid = __builtin_amdgcn_readfirstlane(tid >> 6), lane = tid & 63, wr = wid >> 2, wc = wid & 3, fr = lane & 15, fq = lane >> 4;
    const int K = g.K, nt = K / BK;
    unsigned voffA[2], voffB[2];
#pragma unroll
    for (int i = 0; i < 2; ++i) { int R, C; stage_rc(tid * 16 + i * 8192, R, C); const int Rb = Epi::PERM ? ((R & ~31) + perm32(R & 31)) : R;
        voffA[i] = (unsigned)(R * K + C) * 2u; voffB[i] = (unsigned)(Rb * K + C) * 2u; }
    const size_t kstep = (size_t)(BK * 2);
    const size_t hstep = (size_t)HALF * K * 2;
    const size_t tstep = 2 * hstep;
    const unsigned ldsw = (unsigned)wid * 1024u;
    const int aoff = lds_byte(wr * 64 + fr, fq * 8), boff = lds_byte(wc * 32 + fr, fq * 8);
#define PG8_SA(b, h) (((b) * 2 + (h)) * HTB)
#define PG8_SB(b, h) ((4 + (b) * 2 + (h)) * HTB)
#define PG8_STAGE(bufoff, gbase, voff) do { const char* gb_ = (const char*)(gbase); asm volatile("" : "+s"(gb_));     \
        _Pragma("unroll") for (int _i = 0; _i < 2; ++_i) \
        __builtin_amdgcn_global_load_lds((const unsigned*)(gb_ + (voff)[_i]), (PG8_LAS unsigned*)(lds + (bufoff) + ldsw + _i * 8192), 16, 0, 0); } while (0)
#define PG8_LDA(dst, b, h) do { _Pragma("unroll") for (int m = 0; m < 4; ++m) _Pragma("unroll") for (int k = 0; k < 2; ++k) dst[m][k] = *(const PG8_LAS bf16x8*)(lds + PG8_SA(b, h) + aoff + m * 2048 + k * 1024); } while (0)
#define PG8_LDB(dst, b, h) do { _Pragma("unroll") for (int n = 0; n < 2; ++n) _Pragma("unroll") for (int k = 0; k < 2; ++k) dst[n][k] = *(const PG8_LAS bf16x8*)(lds + PG8_SB(b, h) + boff + n * 2048 + k * 1024); } while (0)
#define PG8_MMA(ai, bj, At, Bt) do { __builtin_amdgcn_s_setprio(1); _Pragma("unroll") for (int m = 0; m < 4; ++m) _Pragma("unroll") for (int n = 0; n < 2; ++n) _Pragma("unroll") for (int k = 0; k < 2; ++k) \
        acc[ai][bj][m][n] = __builtin_amdgcn_mfma_f32_16x16x32_bf16(Bt[n][k], At[m][k], acc[ai][bj][m][n], 0, 0, 0); __builtin_amdgcn_s_setprio(0); } while (0)
#define PG8_WAIT_V(n) asm volatile("s_waitcnt vmcnt(" #n ")" ::: "memory")
#define PG8_WAIT_VN(n) asm volatile("s_waitcnt vmcnt(%0)" :: "n"(n) : "memory")
#define PG8_WAIT_L(n) asm volatile("s_waitcnt lgkmcnt(" #n ")" ::: "memory")
#define PG8_BAR __builtin_amdgcn_s_barrier()
#define PG8_SCHED __builtin_amdgcn_sched_barrier(0)
    Unit cur, nxt; int ui = 0;
    if (!S.next(0, cur)) return;
    f32x4 acc[2][2][4][2];
#pragma unroll
    for (int a = 0; a < 2; ++a)
#pragma unroll
        for (int b = 0; b < 2; ++b)
#pragma unroll
            for (int m = 0; m < 4; ++m)
#pragma unroll
                for (int n = 0; n < 2; ++n) acc[a][b][m][n] = (f32x4){0.f, 0.f, 0.f, 0.f};
    bf16x8 At[4][2], B0[2][2], B1[2][2];
    const char* cA = (const char*)g.A + (size_t)cur.pm * tstep; const char* cB = (const char*)g.Bt + (size_t)cur.pn * tstep;
    S.a_ready(cur);
    if constexpr (SP2) {
        PG8_STAGE(PG8_SB(0, 0), cB, voffB); PG8_STAGE(PG8_SB(0, 1), cB + hstep, voffB); PG8_STAGE(PG8_SA(0, 0), cA, voffA); PG8_STAGE(PG8_SA(0, 1), cA + hstep, voffA);
        if (wr == 1) PG8_BAR;
        PG8_WAIT_V(2); PG8_BAR;
        PG8_STAGE(PG8_SB(1, 0), cB + kstep, voffB); PG8_STAGE(PG8_SA(1, 0), cA + kstep, voffA); PG8_STAGE(PG8_SB(1, 1), cB + hstep + kstep, voffB);
        PG8_WAIT_V(6); PG8_BAR;
    } else {
        PG8_STAGE(PG8_SB(0, 0), cB, voffB); PG8_STAGE(PG8_SA(0, 0), cA, voffA); PG8_STAGE(PG8_SB(0, 1), cB + hstep, voffB); PG8_STAGE(PG8_SA(0, 1), cA + hstep, voffA);
        if (wr == 1) PG8_BAR;
        PG8_WAIT_V(4); PG8_BAR;
        PG8_STAGE(PG8_SB(1, 0), cB + kstep, voffB); PG8_STAGE(PG8_SA(1, 0), cA + kstep, voffA); PG8_STAGE(PG8_SB(1, 1), cB + hstep + kstep, voffB);
        PG8_WAIT_V(6); PG8_BAR;
    }
    for (;;) {
        const bool has_next = S.next(ui + 1, nxt);
        const char* nA = has_next ? (const char*)g.A + (size_t)nxt.pm * tstep : cA; const char* nB = has_next ? (const char*)g.Bt + (size_t)nxt.pn * tstep : cB;
        for (int t = 0; t < nt; t += 2) {
            if constexpr (Epi::HOOKT >= 0) { if (t == Epi::HOOKT) E.hook(acc, cur, wr, wc, fr, fq); }
            const bool last = (t == nt - 2);
            const char* a1 = cA + (size_t)(t + 1) * kstep;
            const char* a2 = last ? nA : cA + (size_t)(t + 2) * kstep; const char* b2 = last ? nB : cB + (size_t)(t + 2) * kstep;
            const char* a3 = a2 + kstep; const char* b3 = b2 + kstep;
            if (last && has_next) S.a_ready(nxt);
            if constexpr (SP2) {
            const bool relax = (Epi::NST > 0) && (t == 0) && (ui > 0);
            PG8_LDB(B0, 0, 0); PG8_LDB(B1, 0, 1); PG8_SCHED; PG8_LDA(At, 0, 0); PG8_STAGE(PG8_SA(1, 1), a1 + hstep, voffA);
            if (relax) { PG8_WAIT_VN(8 + Epi::NST); } else { PG8_WAIT_V(8); } PG8_WAIT_L(0); PG8_BAR; PG8_MMA(0, 0, At, B0); PG8_MMA(0, 1, At, B1); PG8_BAR; PG8_SCHED;
            PG8_LDA(At, 0, 1); PG8_STAGE(PG8_SB(0, 0), b2, voffB); PG8_STAGE(PG8_SB(0, 1), b2 + hstep, voffB); PG8_STAGE(PG8_SA(0, 0), a2, voffA);
            if (relax) { PG8_WAIT_VN(8 + Epi::NST); } else { PG8_WAIT_V(8); } PG8_WAIT_L(0); PG8_BAR; PG8_MMA(1, 0, At, B0); PG8_MMA(1, 1, At, B1); PG8_BAR; PG8_SCHED;
            PG8_LDB(B0, 1, 0); PG8_LDB(B1, 1, 1); PG8_SCHED; PG8_LDA(At, 1, 0); PG8_STAGE(PG8_SA(0, 1), a2 + hstep, voffA);
            PG8_WAIT_V(8); PG8_WAIT_L(0); PG8_BAR; PG8_MMA(0, 0, At, B0); PG8_MMA(0, 1, At, B1); PG8_BAR; PG8_SCHED;
            PG8_LDA(At, 1, 1); PG8_STAGE(PG8_SB(1, 0), b3, voffB); PG8_STAGE(PG8_SB(1, 1), b3 + hstep, voffB); PG8_STAGE(PG8_SA(1, 0), a3, voffA);
            PG8_WAIT_V(8); PG8_WAIT_L(0); PG8_BAR; PG8_MMA(1, 0, At, B0); PG8_MMA(1, 1, At, B1); PG8_BAR; PG8_SCHED;
            } else {
            PG8_LDB(B0, 0, 0); PG8_SCHED; PG8_LDA(At, 0, 0); PG8_STAGE(PG8_SA(1, 1), a1 + hstep, voffA);
            PG8_WAIT_L(8); PG8_BAR; PG8_WAIT_L(0); PG8_MMA(0, 0, At, B0); PG8_BAR; PG8_SCHED;
            PG8_LDB(B1, 0, 1); PG8_STAGE(PG8_SB(0, 0), b2, voffB);
            PG8_BAR; PG8_WAIT_L(0); PG8_MMA(0, 1, At, B1); PG8_BAR;
            PG8_LDA(At, 0, 1); PG8_STAGE(PG8_SA(0, 0), a2, voffA);
            PG8_BAR; PG8_WAIT_L(0); PG8_MMA(1, 0, At, B0); PG8_BAR; PG8_SCHED;
            PG8_STAGE(PG8_SB(0, 1), b2 + hstep, voffB);
            PG8_WAIT_V(6); PG8_BAR; PG8_MMA(1, 1, At, B1); PG8_BAR;
            PG8_LDB(B0, 1, 0); PG8_SCHED; PG8_LDA(At, 1, 0); PG8_STAGE(PG8_SA(0, 1), a2 + hstep, voffA);
            PG8_WAIT_L(8); PG8_BAR; PG8_WAIT_L(0); PG8_MMA(0, 0, At, B0); PG8_BAR; PG8_SCHED;
            PG8_LDB(B1, 1, 1); PG8_STAGE(PG8_SB(1, 0), b3, voffB);
            PG8_BAR; PG8_WAIT_L(0); PG8_MMA(0, 1, At, B1); PG8_BAR;
            PG8_LDA(At, 1, 1); PG8_STAGE(PG8_SA(1, 0), a3, voffA);
            PG8_BAR; PG8_WAIT_L(0); PG8_MMA(1, 0, At, B0); PG8_BAR; PG8_SCHED;
            PG8_STAGE(PG8_SB(1, 1), b3 + hstep, voffB);
            PG8_WAIT_V(6); PG8_BAR; PG8_MMA(1, 1, At, B1); PG8_BAR;
            }
        }
        if constexpr (ALIGN_EPI) { if (wr == 0) PG8_BAR; }
        if constexpr (!Epi::AFTER_DRAIN) { E(acc, cur, wr, wc, fr, fq); S.done(cur); }
        if (!has_next) break;
#pragma unroll
        for (int a = 0; a < 2; ++a)
#pragma unroll
            for (int b = 0; b < 2; ++b)
#pragma unroll
                for (int m = 0; m < 4; ++m)
#pragma unroll
                    for (int n = 0; n < 2; ++n) acc[a][b][m][n] = (f32x4){0.f, 0.f, 0.f, 0.f};
        cur = nxt; cA = nA; cB = nB; ++ui;
        if constexpr (ALIGN_EPI) { if (wr == 1) PG8_BAR; }
    }
    PG8_WAIT_V(0);
    if constexpr (!ALIGN_EPI) { if (wr == 0) PG8_BAR; }
    PG8_BAR;
    if constexpr (Epi::AFTER_DRAIN) { E.fused(acc, cur, wr, wc, fr, fq, lds, wid, lane); S.done(cur); }
#undef PG8_SA
#undef PG8_SB
#undef PG8_STAGE
#undef PG8_LDA
#undef PG8_LDB
#undef PG8_MMA
#undef PG8_WAIT_V
#undef PG8_WAIT_VN
#undef PG8_WAIT_L
#undef PG8_BAR
#undef PG8_SCHED
}
}

using pg8::bf16_t; using pg8::bf16x8; using pg8::f32x4; using pg8::u32x4; using pg8::cvt_pk_bf16;
#define LAS __attribute__((address_space(3)))
typedef short v4i16_t __attribute__((ext_vector_type(4)));
typedef unsigned u32x2 __attribute__((ext_vector_type(2)));

constexpr int DM = 1024, SEQ = 2048, BATCH = 32, MTOT = BATCH * SEQ, INW = 7680, DFF = 2816, PLED = 256, DEPTH = 2;
#ifndef MK_NCH
#define MK_NCH 2
#endif
constexpr int NCH = MK_NCH, MC = MTOT / NCH, NBC = BATCH / NCH;
constexpr float RMS_EPS = 1e-6f;
constexpr float QSCALE = 0.08838834764831845f * 1.4426950408889634f;
constexpr int NTHREADS = 512;
constexpr int RS_UNITS = 20;
constexpr int LDS_RS = 131072 + 1024;
constexpr int LDS_CW = LDS_RS + RS_UNITS * 1024;
constexpr int LDS_BYTES = LDS_CW + 4096;
static_assert(LDS_BYTES <= 163840, "LDS map");
#ifndef MK_SINGLE
#define MK_SINGLE 1
#endif

constexpr size_t al1m(size_t x) { return (x + 1048575) & ~(size_t)1048575; }
constexpr size_t SZ_WIN = (size_t)INW * DM * 2, SZ_WYA = (size_t)1024 * 512 * 2, SZ_WB = (size_t)1024 * 1024 * 2, SZ_WO = SZ_WB, SZ_WUP = (size_t)2 * DFF * DM * 2,
                 SZ_WDN = (size_t)DM * DFF * 2, SZ_WPLE = (size_t)1024 * 256 * 2, SZ_WPG = SZ_WB;
constexpr size_t WO_IN = 0, WO_YA = WO_IN + SZ_WIN, WO_B = WO_YA + SZ_WYA, WO_O = WO_B + SZ_WB, WO_UP = WO_O + SZ_WO, WO_DN = WO_UP + SZ_WUP, WO_PLE = WO_DN + SZ_WDN,
                 WO_PG = WO_PLE + SZ_WPLE, SZ_WL = WO_PG + SZ_WPG;
constexpr size_t O_BAR = 524288;
constexpr size_t O_ROPE = 0;
constexpr size_t O_SSA = (size_t)1 << 20, O_SSB = O_SSA + (size_t)MTOT * 64, O_SSC = O_SSB + (size_t)MTOT * 64;
constexpr size_t O_W = al1m(O_SSC + (size_t)MTOT * 64);
constexpr size_t O_XB0 = al1m(O_W + 2 * SZ_WL);
constexpr size_t O_PB = O_XB0 + (size_t)MTOT * DM * 2;
constexpr size_t O_Q = O_PB + (size_t)2 * MTOT * PLED * 2;
constexpr size_t O_ACT = O_Q;
constexpr size_t O_T1 = O_Q + (size_t)2 * MC * 1536 * 2;
constexpr size_t O_UP = O_Q + (size_t)3 * MC * 1536 * 2;
constexpr size_t O_PW = O_UP;
constexpr size_t O_HB = O_UP + (size_t)MC * 1024 * 2;
constexpr size_t O_OG = O_UP + (size_t)3 * MC * 1024 * 2;
constexpr size_t O_MERGED = O_OG;
constexpr size_t O_XB2 = O_OG;
constexpr size_t O_LSE = O_OG + (size_t)3 * MC * 512 * 2;
constexpr size_t O_ATTN = O_LSE + (size_t)3 * MC * 4 * 4;
constexpr size_t O_POOLED = O_ATTN + (size_t)MC * 512 * 2;
constexpr size_t O_XB1 = O_POOLED;
constexpr size_t O_END = O_POOLED + (size_t)MC * 1024 * 2;
static_assert((size_t)(MC / 64) * 4 * 2 * DFF * 4 <= (size_t)MC * 1024 * 2, "halo buffer fits in the gate_a region");
static_assert((size_t)MC * DFF * 2 <= (size_t)2 * MC * 1536 * 2, "act fits in the q,k region");
static_assert(O_END <= ((size_t)1 << 30), "workspace map fits in 1 GiB");

struct Args { const float* in[18]; float* out; unsigned char* ws; int lo, hi; };
__device__ __forceinline__ double inv_freq(int j) {
    const double lt = -0.8201018507344862;
    double r = 1.0;
    if (j & 1) r *= 0.4403666026717805; if (j & 2) r *= 0.1939227447486858; if (j & 4) r *= 0.03760603093086394; if (j & 8) r *= 0.0014142135623730955;
    (void)lt; return r;
}

__device__ __forceinline__ float sigm(float x) { return __builtin_amdgcn_rcpf(1.f + __builtin_amdgcn_exp2f(-1.4426950408889634f * x)); }
__device__ __forceinline__ float rowscale(const float* part, int row) {
    const f32x4* p = (const f32x4*)(part + (size_t)row * 16);
    const f32x4 a = p[0], b = p[1], c = p[2], d = p[3];
    const float s = (((a[0] + a[1]) + (a[2] + a[3])) + ((b[0] + b[1]) + (b[2] + b[3]))) + (((c[0] + c[1]) + (c[2] + c[3])) + ((d[0] + d[1]) + (d[2] + d[3])));
    return __builtin_amdgcn_rsqf(s * (1.f / 1024.f) + RMS_EPS);
}
__device__ __forceinline__ u32x4 pack8(const f32x4 a, const f32x4 b) { u32x4 w; w.x = cvt_pk_bf16(a[0], a[1]); w.y = cvt_pk_bf16(a[2], a[3]); w.z = cvt_pk_bf16(b[0], b[1]); w.w = cvt_pk_bf16(b[2], b[3]); return w; }
__device__ __forceinline__ void unpack8(const u32x4 w, f32x4& a, f32x4& b) {
    a[0] = __uint_as_float(w.x << 16); a[1] = __uint_as_float(w.x & 0xffff0000u); a[2] = __uint_as_float(w.y << 16); a[3] = __uint_as_float(w.y & 0xffff0000u);
    b[0] = __uint_as_float(w.z << 16); b[1] = __uint_as_float(w.z & 0xffff0000u); b[2] = __uint_as_float(w.w << 16); b[3] = __uint_as_float(w.w & 0xffff0000u);
}
__device__ __forceinline__ float xsum16(float v) { auto r = __builtin_amdgcn_permlane16_swap(__float_as_uint(v), __float_as_uint(v), false, false); return __uint_as_float(r[0]) + __uint_as_float(r[1]); }
__device__ __forceinline__ float xsum32(float v) { auto r = __builtin_amdgcn_permlane32_swap(__float_as_uint(v), __float_as_uint(v), false, false); return __uint_as_float(r[0]) + __uint_as_float(r[1]); }
__device__ __forceinline__ float xmax16(float v) { auto r = __builtin_amdgcn_permlane16_swap(__float_as_uint(v), __float_as_uint(v), false, false); return fmaxf(__uint_as_float(r[0]), __uint_as_float(r[1])); }
__device__ __forceinline__ float xmax32(float v) { auto r = __builtin_amdgcn_permlane32_swap(__float_as_uint(v), __float_as_uint(v), false, false); return fmaxf(__uint_as_float(r[0]), __uint_as_float(r[1])); }
__device__ __forceinline__ float partner32(float v, bool lower) { auto r = __builtin_amdgcn_permlane32_swap(__float_as_uint(v), __float_as_uint(v), false, false); return __uint_as_float(lower ? r[1] : r[0]); }
#define LDS_WAIT() asm volatile("s_waitcnt lgkmcnt(0)" ::: "memory")

__device__ __forceinline__ void rowscale4(const float* part, int row0, float (&rs)[4]) {
    f32x4 p[4][4];
#pragma unroll
    for (int m = 0; m < 4; ++m) { const f32x4* q = (const f32x4*)(part + (size_t)(row0 + 16 * m) * 16);
#pragma unroll
        for (int j = 0; j < 4; ++j) p[m][j] = q[j]; }
#pragma unroll
    for (int m = 0; m < 4; ++m) {
        float s = 0.f;
#pragma unroll
        for (int j = 0; j < 4; ++j) s += (p[m][j][0] + p[m][j][1]) + (p[m][j][2] + p[m][j][3]);
        rs[m] = __builtin_amdgcn_rsqf(s * (1.f / 1024.f) + RMS_EPS);
    }
    asm volatile("" : "+v"(rs[0]), "+v"(rs[1]), "+v"(rs[2]), "+v"(rs[3]) :: "memory");
}
__device__ __forceinline__ void rs4(const LAS float* tab, const float* part, const pg8::Unit& u, int row0, float (&rs)[4]) {
    if (u.ui < RS_UNITS) {
#pragma unroll
        for (int m = 0; m < 4; ++m) rs[m] = tab[u.ui * 256 + ((row0 + 16 * m) & 255)];
    } else rowscale4(part, row0, rs);
}
struct EpiZ {
    static constexpr bool PERM = true, AFTER_DRAIN = false; static constexpr int HOOKT = -1, NST = 16;
    const float* part; const float* rope; bf16_t* qkv; bf16_t* ugg; const LAS float* rstab;
    template <bool ROT> __device__ __forceinline__ void qkv_half(const f32x4 (&acc)[2][2][4][2], const pg8::Unit& u, int ai, int wr, int wc, int fr, int fq, bf16_t* base, int g, int pp, float qs) const {
        const int sh = 2 * g, row0 = u.pm * 256 + ai * 128 + wr * 64 + fr;
        float rs[4]; rs4(rstab, part, u, row0, rs);
        f32x4 cs[4][2];
        if (ROT) {
#pragma unroll
            for (int m = 0; m < 4; ++m) { const int t = (row0 + 16 * m) & 2047; cs[m][0] = *(const f32x4*)(rope + t * 16 + 4 * fq); cs[m][1] = *(const f32x4*)(rope + 32768 + t * 16 + 4 * fq); }
        }
#pragma unroll
        for (int m = 0; m < 4; ++m) {
            const int row = row0 + 16 * m;
            const float rq = rs[m] * qs;
            const int t = row & 2047, b = row >> 11;
            const int pos = ((t & ((1 << sh) - 1)) << (11 - sh)) + (t >> sh);
#pragma unroll
            for (int bj = 0; bj < 2; ++bj) {
                const int hh = (pp & 1) * 2 + bj;
                f32x4 v0 = acc[ai][bj][m][0] * rq, v1 = acc[ai][bj][m][1] * rq;
                if (ROT) { const f32x4 a0 = v0, a1 = v1; v0 = a0 * cs[m][0] - a1 * cs[m][1]; v1 = a1 * cs[m][0] + a0 * cs[m][1]; }
                bf16_t* dst = base + ((size_t)(((b * 3 + g) * 4 + hh) * 2048 + pos)) * 128 + wc * 32 + 8 * fq;
                *(u32x4*)dst = pack8(v0, v1);
            }
        }
        asm volatile("" ::: "memory");
    }
    __device__ __forceinline__ void operator()(const f32x4 (&acc)[2][2][4][2], const pg8::Unit& u, int wr, int wc, int, int) const {
        int ln_; asm volatile("v_mbcnt_lo_u32_b32 %0, -1, 0\n\tv_mbcnt_hi_u32_b32 %0, -1, %0" : "=v"(ln_)); const int fr = ln_ & 15, fq = ln_ >> 4;
        const int pn = u.pn;
        if (pn < 18) {
            const int kind = pn / 6, pp = pn - kind * 6, g = pp >> 1;
            bf16_t* base = qkv + (size_t)kind * MC * 1536;
            const float qs = (kind == 0) ? QSCALE : 1.f;
            if ((kind < 2) && (wc == 0)) { qkv_half<true>(acc, u, 0, wr, wc, fr, fq, base, g, pp, qs); qkv_half<true>(acc, u, 1, wr, wc, fr, fq, base, g, pp, qs); }
            else { qkv_half<false>(acc, u, 0, wr, wc, fr, fq, base, g, pp, qs); qkv_half<false>(acc, u, 1, wr, wc, fr, fq, base, g, pp, qs); }
        } else {
            const int reg = (pn - 18) >> 2, cb = ((pn - 18) & 3) * 256;
            bf16_t* base = ugg + (size_t)reg * MC * 1024;
#pragma unroll
            for (int ai = 0; ai < 2; ++ai) {
                const int row0 = u.pm * 256 + ai * 128 + wr * 64 + fr;
                float rs[4]; rs4(rstab, part, u, row0, rs);
#pragma unroll
                for (int m = 0; m < 4; ++m)
#pragma unroll
                    for (int bj = 0; bj < 2; ++bj) {
                        bf16_t* dst = base + (size_t)(row0 + 16 * m) * 1024 + cb + bj * 128 + wc * 32 + 8 * fq;
                        *(u32x4*)dst = pack8(acc[ai][bj][m][0] * rs[m], acc[ai][bj][m][1] * rs[m]);
                    }
                asm volatile("" ::: "memory");
            }
        }
    }
};
struct EpiAB {
    static constexpr bool PERM = true, AFTER_DRAIN = false; static constexpr int HOOKT = 8, NST = 16;
    const bf16_t* ga; const bf16_t* gb; bf16_t* merged;
    __device__ __forceinline__ void hook(f32x4 (&acc)[2][2][4][2], const pg8::Unit& u, int wr, int wc, int fr_in, int fq) const {
        int fr = fr_in; asm volatile("" : "+v"(fr));
#pragma unroll
        for (int ai = 0; ai < 2; ++ai) {
                const size_t off0 = (size_t)(u.pm * 256 + ai * 128 + wr * 64 + fr) * 1024 + u.pn * 256 + wc * 32 + 8 * fq;
                u32x4 ain[4][2], bin[4][2];
#pragma unroll
                for (int mm = 0; mm < 4; ++mm)
#pragma unroll
                    for (int bj = 0; bj < 2; ++bj) { ain[mm][bj] = *(const u32x4*)(ga + off0 + (size_t)mm * 16384 + bj * 128); bin[mm][bj] = *(const u32x4*)(gb + off0 + (size_t)mm * 16384 + bj * 128); }
#pragma unroll
                for (int mm = 0; mm < 4; ++mm)
#pragma unroll
                    for (int bj = 0; bj < 2; ++bj) {
                        f32x4 a0, a1, b0, b1; unpack8(ain[mm][bj], a0, a1); unpack8(bin[mm][bj], b0, b1);
#pragma unroll
                        for (int e = 0; e < 4; ++e) {
                            const float ea = __builtin_amdgcn_exp2f(-1.4426950408889634f * a0[e]), eb = __builtin_amdgcn_exp2f(-1.4426950408889634f * fmaxf(b0[e], -30.f));
                            acc[ai][bj][mm][0][e] *= (1.f + eb) * __builtin_amdgcn_rcpf(1.f + ea);
                            const float fa = __builtin_amdgcn_exp2f(-1.4426950408889634f * a1[e]), fb = __builtin_amdgcn_exp2f(-1.4426950408889634f * fmaxf(b1[e], -30.f));
                            acc[ai][bj][mm][1][e] *= (1.f + fb) * __builtin_amdgcn_rcpf(1.f + fa);
                        }
                    }
                asm volatile("" ::: "memory");
        }
    }
    __device__ __forceinline__ void operator()(const f32x4 (&acc)[2][2][4][2], const pg8::Unit& u, int wr, int wc, int, int) const {
        int ln_; asm volatile("v_mbcnt_lo_u32_b32 %0, -1, 0\n\tv_mbcnt_hi_u32_b32 %0, -1, %0" : "=v"(ln_)); const int fr = ln_ & 15, fq = ln_ >> 4;
#pragma unroll
        for (int ai = 0; ai < 2; ++ai) {
            const size_t off0 = (size_t)(u.pm * 256 + ai * 128 + wr * 64 + fr) * 1024 + u.pn * 256 + wc * 32 + 8 * fq;
            u32x4 bin[4][2];
#pragma unroll
            for (int m = 0; m < 4; ++m)
#pragma unroll
                for (int bj = 0; bj < 2; ++bj) bin[m][bj] = *(const u32x4*)(gb + off0 + (size_t)m * 16384 + bj * 128);
#pragma unroll
            for (int m = 0; m < 4; ++m)
#pragma unroll
                for (int bj = 0; bj < 2; ++bj) {
                    f32x4 b0, b1; unpack8(bin[m][bj], b0, b1);
                    f32x4 v0 = acc[ai][bj][m][0], v1 = acc[ai][bj][m][1];
#pragma unroll
                    for (int e = 0; e < 4; ++e) { v0[e] *= sigm(fmaxf(b0[e], -30.f)); v1[e] *= sigm(fmaxf(b1[e], -30.f)); }
                    *(u32x4*)(merged + off0 + (size_t)m * 16384 + bj * 128) = pack8(v0, v1);
                }
            asm volatile("" ::: "memory");
        }
    }
};
template <int MODE> struct EpiRes {
    static constexpr bool PERM = true, AFTER_DRAIN = false; static constexpr int HOOKT = -1, NST = 24;
    const bf16_t* base; bf16_t* xb; float* part; const bf16_t* pw; const float* partin; const LAS float* rstab;
    __device__ __forceinline__ void operator()(const f32x4 (&acc)[2][2][4][2], const pg8::Unit& u, int wr, int wc, int, int) const {
        int ln_; asm volatile("v_mbcnt_lo_u32_b32 %0, -1, 0\n\tv_mbcnt_hi_u32_b32 %0, -1, %0" : "=v"(ln_)); const int fr = ln_ & 15, fq = ln_ >> 4;
#pragma unroll
        for (int ai = 0; ai < 2; ++ai) {
            const int row0 = u.pm * 256 + ai * 128 + wr * 64 + fr;
            const size_t off0 = (size_t)row0 * 1024 + u.pn * 256 + wc * 32 + 8 * fq;
            float rs[4] = {1.f, 1.f, 1.f, 1.f};
            if (MODE == 1) rs4(rstab, partin, u, row0, rs);
            u32x4 bin[4][2], pin[4][2];
#pragma unroll
            for (int m = 0; m < 4; ++m)
#pragma unroll
                for (int bj = 0; bj < 2; ++bj) {
                    bin[m][bj] = *(const u32x4*)(base + off0 + (size_t)m * 16384 + bj * 128);
                    if (MODE == 1) pin[m][bj] = *(const u32x4*)(pw + off0 + (size_t)m * 16384 + bj * 128);
                }
#pragma unroll
            for (int m = 0; m < 4; ++m) {
                float sq = 0.f;
#pragma unroll
                for (int bj = 0; bj < 2; ++bj) {
                    const size_t off = off0 + (size_t)m * 16384 + bj * 128;
                    f32x4 v0, v1; unpack8(bin[m][bj], v0, v1);
                    f32x4 a0 = acc[ai][bj][m][0], a1 = acc[ai][bj][m][1];
                    if (MODE == 1) {
                        f32x4 p0, p1; unpack8(pin[m][bj], p0, p1);
#pragma unroll
                        for (int e = 0; e < 4; ++e) { a0[e] = p0[e] * sigm(rs[m] * a0[e]); a1[e] = p1[e] * sigm(rs[m] * a1[e]); }
                    }
                    v0 += a0; v1 += a1;
                    *(u32x4*)(xb + off) = pack8(v0, v1);
                    sq += ((v0[0] * v0[0] + v0[1] * v0[1]) + (v0[2] * v0[2] + v0[3] * v0[3])) + ((v1[0] * v1[0] + v1[1] * v1[1]) + (v1[2] * v1[2] + v1[3] * v1[3]));
                }
                sq = xsum16(sq); sq = xsum32(sq);
                if (fq == 0) part[(size_t)(row0 + 16 * m) * 16 + u.pn * 4 + wc] = sq;
            }
            asm volatile("" ::: "memory");
        }
    }
};
struct EpiNull {
    static constexpr bool PERM = true, AFTER_DRAIN = false; static constexpr int HOOKT = -1;
    float* sink;
    __device__ __forceinline__ void operator()(const f32x4 (&acc)[2][2][4][2], const pg8::Unit& u, int wr, int wc, int, int) const {
        int ln_; asm volatile("v_mbcnt_lo_u32_b32 %0, -1, 0\n\tv_mbcnt_hi_u32_b32 %0, -1, %0" : "=v"(ln_)); const int fr = ln_ & 15, fq = ln_ >> 4;
        float s = 0.f;
#pragma unroll
        for (int ai = 0; ai < 2; ++ai)
#pragma unroll
            for (int bj = 0; bj < 2; ++bj)
#pragma unroll
                for (int m = 0; m < 4; ++m) s += acc[ai][bj][m][0][0] + acc[ai][bj][m][1][3];
        if (s == 12345.678f) sink[0] = s;
    }
};
struct EpiF32 {
    static constexpr bool PERM = true, AFTER_DRAIN = false; static constexpr int HOOKT = -1, NST = 16;
    bf16_t* o;
    __device__ __forceinline__ void operator()(const f32x4 (&acc)[2][2][4][2], const pg8::Unit& u, int wr, int wc, int, int) const {
        int ln_; asm volatile("v_mbcnt_lo_u32_b32 %0, -1, 0\n\tv_mbcnt_hi_u32_b32 %0, -1, %0" : "=v"(ln_)); const int fr = ln_ & 15, fq = ln_ >> 4;
#pragma unroll
        for (int ai = 0; ai < 2; ++ai)
#pragma unroll
            for (int m = 0; m < 4; ++m) {
                const int row = u.pm * 256 + ai * 128 + wr * 64 + m * 16 + fr;
#pragma unroll
                for (int bj = 0; bj < 2; ++bj) {
                    const size_t off = (size_t)row * 1024 + u.pn * 256 + bj * 128 + wc * 32 + 8 * fq;
                    *(u32x4*)(o + off) = pack8(acc[ai][bj][m][0], acc[ai][bj][m][1]);
                }
            }
    }
};
template <int N> __device__ __forceinline__ float shift_rows(float cur, float prev) {
    const int t = __builtin_amdgcn_update_dpp(0, __float_as_int(prev), 0x120 + N, 0xf, 0xf, false);
    const int r = __builtin_amdgcn_update_dpp(t, __float_as_int(cur), 0x110 + N, 0xf, 0xf, false);
    return __int_as_float(r);
}
__device__ __forceinline__ float silu_mul(float g, float v) { return g * sigm(g) * v; }
struct EpiConv {
    static constexpr bool PERM = true, AFTER_DRAIN = false; static constexpr int HOOKT = -1, NST = 48;
    const float* part; const float* cw; const float* cb; bf16_t* act; float* hb; const LAS float* rstab; LAS float* cwtab;
    __device__ __forceinline__ void operator()(const f32x4 (&acc)[2][2][4][2], const pg8::Unit& u, int wr, int wc, int, int) const {
        int ln_; asm volatile("v_mbcnt_lo_u32_b32 %0, -1, 0\n\tv_mbcnt_hi_u32_b32 %0, -1, %0" : "=v"(ln_)); const int fr = ln_ & 15, fq = ln_ >> 4;
        const int cbase = u.pn * 128 + wc * 32 + 8 * fq, lc = wc * 32 + 8 * fq;
        {
            const int t = wr * 256 + wc * 64 + fq * 16 + fr;
            if (t < 256) { const int k = t >> 5, c4 = (t & 31) * 4, kk = k & 3;
                const float* src = (kk < 3 ? cw + (size_t)kk * 2 * DFF : cb) + (k >> 2) * DFF + u.pn * 128 + c4;
                const f32x4 v = *(const f32x4*)src;
                *(LAS f32x4*)(cwtab + k * 128 + c4) = v; }
            asm volatile("s_waitcnt vmcnt(0) lgkmcnt(0)" ::: "memory"); __builtin_amdgcn_s_barrier(); asm volatile("" ::: "memory");
        }
#pragma unroll
        for (int ai = 0; ai < 2; ++ai) {
            float rs[4]; rs4(rstab, part, u, u.pm * 256 + ai * 128 + wr * 64 + fr, rs);
            const int blk = u.pm * 4 + ai * 2 + wr;
#pragma unroll
            for (int n = 0; n < 2; ++n) {
                const int c0 = cbase + 4 * n;
                const LAS float* ct = cwtab + lc + 4 * n;
                const f32x4 w0g = *(const LAS f32x4*)(ct), w1g = *(const LAS f32x4*)(ct + 128), w2g = *(const LAS f32x4*)(ct + 256), bg = *(const LAS f32x4*)(ct + 384),
                            w0v = *(const LAS f32x4*)(ct + 512), w1v = *(const LAS f32x4*)(ct + 640), w2v = *(const LAS f32x4*)(ct + 768), bv = *(const LAS f32x4*)(ct + 896);
                f32x4 pg = {0.f, 0.f, 0.f, 0.f}, pv = pg;
#pragma unroll
                for (int m = 0; m < 4; ++m) {
                    const int row = u.pm * 256 + ai * 128 + wr * 64 + m * 16 + fr;
                    const f32x4 ug = acc[ai][0][m][n] * rs[m], uv = acc[ai][1][m][n] * rs[m];
                    if (m == 0) { if (fr < 2) { float* h = hb + ((size_t)blk * 4 + fr) * (2 * DFF) + c0; *(f32x4*)h = ug; *(f32x4*)(h + DFF) = uv; } }
                    if (m == 3) { if (fr >= 14) { float* h = hb + ((size_t)blk * 4 + (fr - 12)) * (2 * DFF) + c0; *(f32x4*)h = ug; *(f32x4*)(h + DFF) = uv; } }
                    f32x4 o;
#pragma unroll
                    for (int e = 0; e < 4; ++e) {
                        const float g1 = shift_rows<1>(ug[e], pg[e]), g2 = shift_rows<2>(ug[e], pg[e]);
                        const float v1 = shift_rows<1>(uv[e], pv[e]), v2 = shift_rows<2>(uv[e], pv[e]);
                        const float yg = bg[e] + w2g[e] * ug[e] + w1g[e] * g1 + w0g[e] * g2;
                        const float yv = bv[e] + w2v[e] * uv[e] + w1v[e] * v1 + w0v[e] * v2;
                        o[e] = silu_mul(yg, yv);
                    }
                    u32x2 w; w.x = cvt_pk_bf16(o[0], o[1]); w.y = cvt_pk_bf16(o[2], o[3]);
                    *(u32x2*)(act + (size_t)row * DFF + c0) = w;
                    pg = ug; pv = uv;
                    asm volatile("" ::: "memory");
                }
            }
        }
    }
};

__device__ __forceinline__ void tr_item(const float* W, int ldn, int K, const float* gain, bf16_t* WT, int k0, int ns0, int nd0, LAS float* scr, int lane, bool rperm = false) {
#pragma unroll 16
    for (int i = 0; i < 32; ++i) { const int kk = 2 * i + (lane >> 5); float v = W[(size_t)(k0 + kk) * ldn + ns0 + (lane & 31)]; if (gain) v *= gain[k0 + kk];
        const int c = lane & 31, pc = rperm ? (8 * ((c & 15) >> 2) + 4 * (c >> 4) + (c & 3)) : c;
        scr[kk * 33 + pc] = v; }
    LDS_WAIT();
    const int c = lane & 7;
#pragma unroll
    for (int j = 0; j < 4; ++j) { const int n = (lane >> 3) + 8 * j; const LAS float* s = scr + (8 * c) * 33 + n;
        u32x4 o; o.x = cvt_pk_bf16(s[0 * 33], s[1 * 33]); o.y = cvt_pk_bf16(s[2 * 33], s[3 * 33]); o.z = cvt_pk_bf16(s[4 * 33], s[5 * 33]); o.w = cvt_pk_bf16(s[6 * 33], s[7 * 33]);
        *(u32x4*)(WT + (size_t)(nd0 + n) * K + k0 + 8 * c) = o; }
    LDS_WAIT();
}
__device__ __forceinline__ float wave_sum(float v) {
#pragma unroll
    for (int o = 1; o < 64; o <<= 1) v += __shfl_xor(v, o);
    return v;
}
__device__ __forceinline__ void prologue(const Args& a, LAS unsigned char* lds, const int tid_in) {
    int tid_ = tid_in; asm volatile("" : "+v"(tid_));
    const int tid = tid_, lane = tid & 63, wid = tid >> 6;
    const int gw = blockIdx.x * 8 + wid, NGW = gridDim.x * 8;
    const int gt = blockIdx.x * NTHREADS + tid, NT = gridDim.x * NTHREADS;
    unsigned char* ws = a.ws;
    {
        LAS float* scr = (LAS float*)(lds + wid * 16384);
        constexpr int I_IN = 16 * 240, I_YA = 8 * 32, I_O = 16 * 32, I_UP = 16 * 176, I_DN = 44 * 32, I_PLE = 4 * 32, I_PG = 16 * 32;
        constexpr int I_L = I_IN + I_YA + I_O + I_UP + I_DN + I_PLE + I_PG;
        for (int it = gw; it < 2 * I_L; it += NGW) {
            const int l = it / I_L; int r = it - l * I_L;
            unsigned char* wl = ws + O_W + (size_t)l * SZ_WL;
            if (r < I_IN) { const int kb = r / 240, nb = r % 240; tr_item(a.in[3] + (size_t)l * DM * INW, INW, DM, a.in[2] + l * DM, (bf16_t*)(wl + WO_IN), kb * 64, nb * 32, nb * 32, scr, lane, (nb < 96) && ((nb & 3) == 0)); continue; } r -= I_IN;
            if (r < I_YA) { const int kb = r / 32, nb = r % 32; tr_item(a.in[4] + (size_t)l * 512 * DM, DM, 1536, nullptr, (bf16_t*)(wl + WO_YA), kb * 64, nb * 32, nb * 32, scr, lane); continue; } r -= I_YA;
            if (r < I_O) { const int kb = r / 32, nb = r % 32; tr_item(a.in[8] + (size_t)l * DM * DM, DM, DM, nullptr, (bf16_t*)(wl + WO_O), kb * 64, nb * 32, nb * 32, scr, lane); continue; } r -= I_O;
            if (r < I_UP) { const int kb = r / 176, nb = r % 176; const int nd0 = nb * 32, pn = nd0 >> 8, bj = (nd0 >> 7) & 1, cc = nd0 & 127;
                tr_item(a.in[10] + (size_t)l * DM * 2 * DFF, 2 * DFF, DM, a.in[9] + l * DM, (bf16_t*)(wl + WO_UP), kb * 64, bj * DFF + pn * 128 + cc, nd0, scr, lane); continue; } r -= I_UP;
            if (r < I_DN) { const int kb = r / 32, nb = r % 32; tr_item(a.in[13] + (size_t)l * DFF * DM, DM, DFF, nullptr, (bf16_t*)(wl + WO_DN), kb * 64, nb * 32, nb * 32, scr, lane); continue; } r -= I_DN;
            if (r < I_PLE) { const int kb = r / 32, nb = r % 32; tr_item(a.in[15] + (size_t)l * PLED * DM, DM, PLED, nullptr, (bf16_t*)(wl + WO_PLE), kb * 64, nb * 32, nb * 32, scr, lane); continue; } r -= I_PLE;
            { const int kb = r / 32, nb = r % 32; tr_item(a.in[16] + (size_t)l * DM * DM, DM, DM, a.in[14] + l * DM, (bf16_t*)(wl + WO_PG), kb * 64, nb * 32, nb * 32, scr, lane); }
        }
    }
    {
        LAS float* pws = (LAS float*)(lds + wid * 16384);
        for (int it = gw; it < 2 * 64 * 16; it += NGW) {
            const int nb = it & 15, kb = (it >> 4) & 63, l = it >> 10, g = kb >> 4, k0 = (kb & 15) * 16, n = nb * 64 + lane;
            const float* pwp = a.in[6] + ((size_t)(l * 4 + g) * 256 + k0) * 256;
            LDS_WAIT();
#pragma unroll
            for (int i = 0; i < 16; ++i) *(LAS f32x4*)(pws + (i * 64 + lane) * 4) = *(const f32x4*)(pwp + (i * 64 + lane) * 4);
            LDS_WAIT();
            const float* wy = a.in[5] + (size_t)l * DM * DM + (size_t)(g * 256) * DM + n;
            const float* ps = a.in[7] + l * DM + g * 256;
            float s[16];
#pragma unroll
            for (int kk = 0; kk < 16; ++kk) s[kk] = 0.f;
#pragma unroll 4
            for (int j = 0; j < 256; j += 4) {
                float y[4];
#pragma unroll
                for (int jj = 0; jj < 4; ++jj) y[jj] = wy[(size_t)(j + jj) * DM] * ps[j + jj];
#pragma unroll
                for (int kk = 0; kk < 16; ++kk) { const f32x4 p = *(const LAS f32x4*)(pws + kk * 256 + j); s[kk] += (p[0] * y[0] + p[1] * y[1]) + (p[2] * y[2] + p[3] * y[3]); }
            }
            bf16_t* dst = (bf16_t*)(ws + O_W + (size_t)l * SZ_WL + WO_YA) + (size_t)n * 1536 + 512 + g * 256 + k0;
            u32x4 o0, o1;
            o0.x = cvt_pk_bf16(s[0], s[1]); o0.y = cvt_pk_bf16(s[2], s[3]); o0.z = cvt_pk_bf16(s[4], s[5]); o0.w = cvt_pk_bf16(s[6], s[7]);
            o1.x = cvt_pk_bf16(s[8], s[9]); o1.y = cvt_pk_bf16(s[10], s[11]); o1.z = cvt_pk_bf16(s[12], s[13]); o1.w = cvt_pk_bf16(s[14], s[15]);
            *(u32x4*)dst = o0; *(u32x4*)(dst + 8) = o1;
        }
        LDS_WAIT();
    }
    {
        const float* x = a.in[0]; bf16_t* xb = (bf16_t*)(ws + O_XB0); float* ssa = (float*)(ws + O_SSA);
        for (int row = gw; row < MTOT; row += 4 * NGW) {
            f32x4 v[4][4]; float s[4];
#pragma unroll
            for (int q = 0; q < 4; ++q) { const int r = row + q * NGW; const f32x4* xr = (const f32x4*)(x + (size_t)(r < MTOT ? r : row) * DM) + lane;
#pragma unroll
                for (int j = 0; j < 4; ++j) v[q][j] = xr[64 * j]; }
#pragma unroll
            for (int q = 0; q < 4; ++q) { float t = 0.f;
#pragma unroll
                for (int j = 0; j < 4; ++j) t += (v[q][j][0] * v[q][j][0] + v[q][j][1] * v[q][j][1]) + (v[q][j][2] * v[q][j][2] + v[q][j][3] * v[q][j][3]);
                s[q] = wave_sum(t); }
#pragma unroll
            for (int q = 0; q < 4; ++q) { const int r = row + q * NGW; if (r < MTOT) {
                u32x2* o8 = (u32x2*)(xb + (size_t)r * DM) + lane;
#pragma unroll
                for (int j = 0; j < 4; ++j) { u32x2 w; w.x = cvt_pk_bf16(v[q][j][0], v[q][j][1]); w.y = cvt_pk_bf16(v[q][j][2], v[q][j][3]); o8[64 * j] = w; }
                if (lane < 16) ssa[(size_t)r * 16 + lane] = (lane == 0) ? s[q] : 0.f; } }
        }
    }
    {
        const f32x4* p = (const f32x4*)a.in[1]; u32x4* pb = (u32x4*)(ws + O_PB);
#pragma unroll 4
        for (int id = gt; id < 2 * MTOT * PLED / 8; id += NT) pb[id] = pack8(p[2 * id], p[2 * id + 1]);
    }
    for (int id = gt; id < 2048 * 16; id += NT) {
        const int pos = id >> 4, j = id & 15;
        const double rev = (double)pos * inv_freq(j) * 0.15915494309189535;
        const float fr_ = (float)(rev - __builtin_rint(rev));
        float* rope = (float*)(ws + O_ROPE);
        rope[id] = __builtin_amdgcn_cosf(fr_); rope[32768 + id] = __builtin_amdgcn_sinf(fr_);
    }
}

__device__ __forceinline__ int fK(int row) { return (row & 3) | (((row >> 3) & 3) << 2); }
__device__ __forceinline__ int gV(int row) { return (row & 3) | (((row >> 3) & 1) << 2); }
#define ATT_BAR() do { asm volatile("s_waitcnt lgkmcnt(0)" ::: "memory"); __builtin_amdgcn_s_barrier(); asm volatile("" ::: "memory"); } while (0)
struct AttnItem { size_t own; int g, b, h, r, n; bool has_prev, load_prev; };
__device__ __forceinline__ AttnItem attn_item(int v, int i) {
    AttnItem it; const int job = i >> 2, k = i & 3;
    if (job == 0) { const int sA = v >> 2, seg = v & 3; it.g = 0; it.b = sA >> 2; it.h = sA & 3; it.r = 0; it.n = 4 * seg + k; it.has_prev = it.n > 0; it.load_prev = (k == 0) && (seg > 0); }
    else if (job == 1) { it.g = 1; it.b = v >> 4; it.h = (v >> 2) & 3; it.r = v & 3; it.n = k; it.has_prev = k > 0; it.load_prev = false; }
    else { const int idx = 4 * v + k; it.g = 2; it.b = idx >> 6; it.h = (idx >> 4) & 3; it.r = idx & 15; it.n = 0; it.has_prev = false; it.load_prev = false; }
    const int sh = 2 * it.g;
    it.own = ((size_t)((it.b * 3 + it.g) * 4 + it.h) * 2048 + ((size_t)it.r << (11 - sh)) + (size_t)it.n * 128) * 128;
    return it;
}
__device__ __forceinline__ void attn_phase(LAS unsigned char* lds, const bf16_t* Q, const bf16_t* K, const bf16_t* V, bf16_t* OG, float* LSE, const int tid_in) {
    int tid_ = tid_in; asm volatile("" : "+v"(tid_));
    const int tid = tid_, lane = tid & 63, wid = __builtin_amdgcn_readfirstlane(tid >> 6), fr = lane & 15, fq = lane >> 4;
    const int rt = tid >> 4, ch = tid & 15;
    const int kst = rt * 256 + ((ch ^ fK(rt)) << 4), vst = 65536 + rt * 256 + (((ch >> 1) ^ gV(rt)) << 5) + ((ch & 1) << 4);
    const size_t gsrc = (size_t)rt * 128 + ch * 8;
    const int kb0 = wid < 6 ? wid : 6;
    const int fk = (fr & 3) | (((2 * kb0 + (fr >> 2)) & 3) << 2);
    const int kbase = (16 * kb0 + 8 * (fr >> 2) + (fr & 3)) * 256;
    const int gv = ((fr >> 2) & 3) | ((fq & 1) << 2);
    const int vbase = (16 * kb0 + 8 * fq + (fr >> 2)) * 256 + 8 * (fr & 3);
    { unsigned z0; asm volatile("v_mov_b32 %0, 0" : "=v"(z0));
      const u32x4 zz = {z0, z0, z0, z0};
#pragma unroll
      for (int i = 0; i < 16; ++i) *(LAS u32x4*)(lds + (i * 512 + tid) * 16) = zz; }
    for (int v = blockIdx.x; v < NBC * 16; v += gridDim.x) {
        AttnItem cur = attn_item(v, 0);
        u32x4 kreg[4], vreg[4]; bf16x8 qn[4];
#pragma unroll
        for (int i = 0; i < 4; ++i) { kreg[i] = *(const u32x4*)(K + cur.own + gsrc + (size_t)i * 4096); vreg[i] = *(const u32x4*)(V + cur.own + gsrc + (size_t)i * 4096); }
#pragma unroll
        for (int ks = 0; ks < 4; ++ks) qn[ks] = *(const bf16x8*)(Q + cur.own + (size_t)(wid * 16 + fr) * 128 + 8 * fq + 32 * ks);
        for (int it = 0; it < 12; ++it) {
            const int tog = it & 1, tx = (tog ^ 1) << 15;
            ATT_BAR();
#pragma unroll
            for (int i = 0; i < 4; ++i) { *(LAS u32x4*)(lds + tog * 32768 + kst + i * 8192) = kreg[i]; *(LAS u32x4*)(lds + tog * 32768 + vst + i * 8192) = vreg[i]; }
            bf16x8 qf[4];
#pragma unroll
            for (int ks = 0; ks < 4; ++ks) qf[ks] = qn[ks];
            if (cur.load_prev) {
#pragma unroll
                for (int i = 0; i < 4; ++i) { kreg[i] = *(const u32x4*)(K + cur.own - 16384 + gsrc + (size_t)i * 4096); vreg[i] = *(const u32x4*)(V + cur.own - 16384 + gsrc + (size_t)i * 4096); }
#pragma unroll
                for (int i = 0; i < 4; ++i) { *(LAS u32x4*)(lds + (tog ^ 1) * 32768 + kst + i * 8192) = kreg[i]; *(LAS u32x4*)(lds + (tog ^ 1) * 32768 + vst + i * 8192) = vreg[i]; }
            }
            const AttnItem me = cur;
            if (it + 1 < 12) {
                cur = attn_item(v, it + 1);
#pragma unroll
                for (int i = 0; i < 4; ++i) { kreg[i] = *(const u32x4*)(K + cur.own + gsrc + (size_t)i * 4096); vreg[i] = *(const u32x4*)(V + cur.own + gsrc + (size_t)i * 4096); }
#pragma unroll
                for (int ks = 0; ks < 4; ++ks) qn[ks] = *(const bf16x8*)(Q + cur.own + (size_t)(wid * 16 + fr) * 128 + 8 * fq + 32 * ks);
            }
            ATT_BAR();
            f32x4 SA[5], SB[5];
#pragma unroll
            for (int gp = 0; gp < 5; ++gp) { SA[gp] = (f32x4){0.f, 0.f, 0.f, 0.f}; SB[gp] = SA[gp]; }
            int agp[5], bgp[5];
#pragma unroll
            for (int gp = 0; gp < 5; ++gp) { agp[gp] = (kbase + gp * 8192) ^ tx; bgp[gp] = 65536 + ((vbase + gp * 8192) ^ tx); asm volatile("" : "+v"(agp[gp]), "+v"(bgp[gp])); }
            bf16x8 fa[2][10];
            { int kc = ((fq + 0) ^ fk) << 4; asm volatile("" : "+v"(kc));
#pragma unroll
              for (int gp = 0; gp < 5; ++gp) { const LAS unsigned char* pa = lds + (agp[gp] + kc); fa[0][2 * gp] = *(const LAS bf16x8*)(pa); fa[0][2 * gp + 1] = *(const LAS bf16x8*)(pa + 1024); } }
#pragma unroll
            for (int ks = 0; ks < 4; ++ks) {
                if (ks < 3) { int kc = ((fq + 4 * (ks + 1)) ^ fk) << 4; asm volatile("" : "+v"(kc));
#pragma unroll
                    for (int gp = 0; gp < 5; ++gp) { const LAS unsigned char* pa = lds + (agp[gp] + kc); fa[(ks + 1) & 1][2 * gp] = *(const LAS bf16x8*)(pa); fa[(ks + 1) & 1][2 * gp + 1] = *(const LAS bf16x8*)(pa + 1024); } }
                __builtin_amdgcn_sched_barrier(0);
#pragma unroll
                for (int gp = 0; gp < 5; ++gp) {
                    SA[gp] = __builtin_amdgcn_mfma_f32_16x16x32_bf16(fa[ks & 1][2 * gp], qf[ks], SA[gp], 0, 0, 0);
                    SB[gp] = __builtin_amdgcn_mfma_f32_16x16x32_bf16(fa[ks & 1][2 * gp + 1], qf[ks], SB[gp], 0, 0, 0);
                }
                __builtin_amdgcn_sched_barrier(0);
            }
            const int qi = 16 * wid + fr; const int kmin = me.has_prev ? qi : (qi > 128 ? qi : 128);
            float mx = -INFINITY;
#pragma unroll
            for (int gp = 0; gp < 5; ++gp)
#pragma unroll
                for (int j = 0; j < 4; ++j) {
                    const int kkA = 16 * kb0 + 32 * gp + 8 * fq + j, kkB = kkA + 4;
                    if (!(kkA >= kmin && kkA <= qi + 128)) SA[gp][j] = -INFINITY;
                    if (!(kkB >= kmin && kkB <= qi + 128)) SB[gp][j] = -INFINITY;
                    mx = fmaxf(mx, fmaxf(SA[gp][j], SB[gp][j]));
                }
            mx = xmax16(mx); mx = xmax32(mx);
            float l = 0.f; bf16x8 bP[5];
#pragma unroll
            for (int gp = 0; gp < 5; ++gp) {
                f32x4 pa, pb;
#pragma unroll
                for (int j = 0; j < 4; ++j) { pa[j] = __builtin_amdgcn_exp2f(SA[gp][j] - mx); pb[j] = __builtin_amdgcn_exp2f(SB[gp][j] - mx); l += pa[j] + pb[j]; }
                const u32x4 w = pack8(pa, pb); bP[gp] = __builtin_bit_cast(bf16x8, w);
            }
            l = xsum16(l); l = xsum32(l);
            const float inv_l = __builtin_amdgcn_rcpf(l);
            const int sh = 2 * me.g;
            const int tok = ((me.n * 128 + qi) << sh) + me.r;
            const size_t orow = (size_t)me.g * MC + (size_t)me.b * 2048 + tok;
            v4i16_t fv[2][10];
            { int vc = (0 ^ gv) << 5; asm volatile("" : "+v"(vc));
#pragma unroll
              for (int gp = 0; gp < 5; ++gp) { const LAS unsigned char* pv = lds + (bgp[gp] + vc); fv[0][2 * gp] = __builtin_amdgcn_ds_read_tr16_b64_v4i16((LAS v4i16_t*)(pv)); fv[0][2 * gp + 1] = __builtin_amdgcn_ds_read_tr16_b64_v4i16((LAS v4i16_t*)(pv + 1024)); } }
            bf16_t* op16 = OG + orow * 512 + me.h * 128 + 16 * (fq & 1) + 8 * (fq >> 1);
            u32x2 wprev = {0u, 0u};
#pragma unroll
            for (int d0 = 0; d0 < 8; ++d0) {
                if (d0 < 7) { int vc = ((d0 + 1) ^ gv) << 5; asm volatile("" : "+v"(vc));
#pragma unroll
                    for (int gp = 0; gp < 5; ++gp) { const LAS unsigned char* pv = lds + (bgp[gp] + vc); fv[(d0 + 1) & 1][2 * gp] = __builtin_amdgcn_ds_read_tr16_b64_v4i16((LAS v4i16_t*)(pv)); fv[(d0 + 1) & 1][2 * gp + 1] = __builtin_amdgcn_ds_read_tr16_b64_v4i16((LAS v4i16_t*)(pv + 1024)); } }
                __builtin_amdgcn_sched_barrier(0);
                f32x4 o = {0.f, 0.f, 0.f, 0.f};
#pragma unroll
                for (int gp = 0; gp < 5; ++gp) {
                    const v4i16_t lo = fv[d0 & 1][2 * gp], hi = fv[d0 & 1][2 * gp + 1];
                    const bf16x8 av = {lo[0], lo[1], lo[2], lo[3], hi[0], hi[1], hi[2], hi[3]};
                    o = __builtin_amdgcn_mfma_f32_16x16x32_bf16(av, bP[gp], o, 0, 0, 0);
                }
                u32x2 w; w.x = cvt_pk_bf16(o[0] * inv_l, o[1] * inv_l); w.y = cvt_pk_bf16(o[2] * inv_l, o[3] * inv_l);
                if (d0 & 1) {
                    const auto sx = __builtin_amdgcn_permlane16_swap(wprev.x, w.x, false, false);
                    const auto sy = __builtin_amdgcn_permlane16_swap(wprev.y, w.y, false, false);
                    u32x4 st; st.x = sx[0]; st.y = sy[0]; st.z = sx[1]; st.w = sy[1];
                    *(u32x4*)(op16 + 16 * (d0 - 1)) = st;
                } else wprev = w;
                __builtin_amdgcn_sched_barrier(0);
            }
            if (fq == 0) LSE[orow * 4 + me.h] = mx + __builtin_amdgcn_logf(l);
        }
    }
    __syncthreads();
}
__device__ __forceinline__ void pool_phase(const bf16_t* UP, bf16_t* POOLED, const int tid_in) {
    int tid_ = tid_in; asm volatile("" : "+v"(tid_));
    const int gt = blockIdx.x * NTHREADS + tid_, NT = gridDim.x * NTHREADS;
    constexpr int PR = 32;
    for (int id = gt; id < (MC / PR) * 128; id += NT) {
        const int seg = id >> 7, ch = id & 127, g = ch >> 5, w = 2 << g, row0 = seg * PR, t0 = row0 & 2047;
        const bf16_t* src = UP + (size_t)row0 * 1024 + ch * 8;
        bf16_t* dst = POOLED + (size_t)row0 * 1536 + 512 + ch * 8;
        f32x4 s0 = {0.f, 0.f, 0.f, 0.f}, s1 = s0;
        const int pre = (t0 < w - 1) ? t0 : (w - 1);
        for (int j = 1; j <= pre; ++j) { f32x4 a0, a1; unpack8(*(const u32x4*)(src - (size_t)j * 1024), a0, a1); s0 += a0; s1 += a1; }
#pragma unroll 4
        for (int i = 0; i < PR; ++i) {
            f32x4 u0, u1; unpack8(*(const u32x4*)(src + (size_t)i * 1024), u0, u1);
            s0 += u0; s1 += u1;
            const int t = t0 + i, cnt = (t + 1 < w) ? t + 1 : w;
            const float ic = 1.f / (float)cnt;
            *(u32x4*)(dst + (size_t)i * 1536) = pack8(s0 * ic - u0, s1 * ic - u1);
            if (t >= w - 1) { f32x4 o0, o1; unpack8(*(const u32x4*)(src + (size_t)(i - (w - 1)) * 1024), o0, o1); s0 -= o0; s1 -= o1; }
        }
    }
}
__device__ __forceinline__ void merge_phase(const bf16_t* OG, const float* LSE, bf16_t* ATTN, const int tid_in) {
    int tid_ = tid_in; asm volatile("" : "+v"(tid_));
    const int gt = blockIdx.x * NTHREADS + tid_, NT = gridDim.x * NTHREADS;
    for (int id = gt; id < MC * 64; id += NT) {
        const int row = id >> 6, ch = id & 63, h = ch >> 4;
        const float l0 = LSE[(size_t)row * 4 + h], l1 = LSE[((size_t)MC + row) * 4 + h], l2 = LSE[((size_t)2 * MC + row) * 4 + h];
        const float mx = fmaxf(l0, fmaxf(l1, l2));
        float w0 = __builtin_amdgcn_exp2f(l0 - mx), w1 = __builtin_amdgcn_exp2f(l1 - mx), w2 = __builtin_amdgcn_exp2f(l2 - mx);
        const float inv = 1.f / (w0 + w1 + w2); w0 *= inv; w1 *= inv; w2 *= inv;
        f32x4 a0, a1, b0, b1, c0, c1;
        unpack8(*(const u32x4*)(OG + (size_t)row * 512 + ch * 8), a0, a1);
        unpack8(*(const u32x4*)(OG + ((size_t)MC + row) * 512 + ch * 8), b0, b1);
        unpack8(*(const u32x4*)(OG + ((size_t)2 * MC + row) * 512 + ch * 8), c0, c1);
        *(u32x4*)(ATTN + (size_t)row * 1536 + ch * 8) = pack8(a0 * w0 + b0 * w1 + c0 * w2, a1 * w0 + b1 * w1 + c1 * w2);
    }
}
__device__ __forceinline__ void fixup_phase(const float* hb, const float* cw, const float* cb, bf16_t* act, const int tid_in) {
    int tid_ = tid_in; asm volatile("" : "+v"(tid_));
    const int gt = blockIdx.x * NTHREADS + tid_, NT = gridDim.x * NTHREADS;
    for (int id = gt; id < (MC / 64) * DFF; id += NT) {
        const int blk = id / DFF, j = id - blk * DFF, row0 = blk * 64;
        const bool first = (row0 & 2047) == 0;
        const float* h0 = hb + (size_t)blk * 4 * (2 * DFF) + j;
        const float* hp = h0 - (size_t)4 * (2 * DFF);
        const float u0g = h0[0], u0v = h0[DFF], u1g = h0[2 * DFF], u1v = h0[3 * DFF];
        float m1g = 0.f, m1v = 0.f, m2g = 0.f, m2v = 0.f;
        if (!first) { m2g = hp[2 * (2 * DFF)]; m2v = hp[2 * (2 * DFF) + DFF]; m1g = hp[3 * (2 * DFF)]; m1v = hp[3 * (2 * DFF) + DFF]; }
        const float w0g = cw[j], w1g = cw[2 * DFF + j], w2g = cw[4 * DFF + j], bg = cb[j];
        const float w0v = cw[DFF + j], w1v = cw[3 * DFF + j], w2v = cw[5 * DFF + j], bv = cb[DFF + j];
        const float y0g = bg + w2g * u0g + w1g * m1g + w0g * m2g, y0v = bv + w2v * u0v + w1v * m1v + w0v * m2v;
        const float y1g = bg + w2g * u1g + w1g * u0g + w0g * m1g, y1v = bv + w2v * u1v + w1v * u0v + w0v * m1v;
        act[(size_t)row0 * DFF + j] = (bf16_t)(cvt_pk_bf16(silu_mul(y0g, y0v), 0.f) & 0xffffu);
        act[(size_t)(row0 + 1) * DFF + j] = (bf16_t)(cvt_pk_bf16(silu_mul(y1g, y1v), 0.f) & 0xffffu);
    }
}
__device__ __forceinline__ void final_phase(float* out, const bf16_t* xb, const float* ssa, const float* gf, const int tid_in) {
    int tid_ = tid_in; asm volatile("" : "+v"(tid_));
    const int lane = tid_ & 63, gw = blockIdx.x * 8 + (tid_ >> 6), NGW = gridDim.x * 8;
    for (int row = gw; row < MTOT; row += NGW) {
        const float rs = rowscale(ssa, row);
        const u32x4* xr = (const u32x4*)(xb + (size_t)row * DM) + lane; f32x4* orow = (f32x4*)(out + (size_t)row * DM) + 2 * lane; const f32x4* gr = (const f32x4*)gf + 2 * lane;
#pragma unroll
        for (int j = 0; j < 2; ++j) { f32x4 v0, v1; unpack8(xr[64 * j], v0, v1); orow[128 * j] = v0 * rs * gr[128 * j]; orow[128 * j + 1] = v1 * rs * gr[128 * j + 1]; }
    }
}

#define XB_TMO      128
#define XB_XCNT(j)  (256  + 64 * (j))
#define XB_XSUB(j)  (1280 + 64 * (j))
#define XB_XGEN(j)  (2304 + 64 * (j))
#define XB_TOP      3328
#define XB_TOPGEN   3392
#define XCD_BAR_WORDS 3456
#define XB_SPIN_CAP (1u << 18)

__device__ __forceinline__ unsigned xb_ld(unsigned* p)              { return __hip_atomic_load(p, __ATOMIC_RELAXED, __HIP_MEMORY_SCOPE_AGENT); }
__device__ __forceinline__ unsigned xb_add(unsigned* p, unsigned v) { return __hip_atomic_fetch_add(p, v, __ATOMIC_RELAXED, __HIP_MEMORY_SCOPE_AGENT); }
__device__ __forceinline__ unsigned xb_xcc_id() { return (unsigned)__builtin_amdgcn_s_getreg((3 << 11) | 20) & 0xFu; }
#define XB_SPIN(cond, bar) do { unsigned _sp = 0; while (cond) { __builtin_amdgcn_s_sleep(1); \
    if ((++_sp & 255u) == 0u) { if (xb_ld(&(bar)[XB_TMO])) break; if (_sp > XB_SPIN_CAP) { atomicAdd(&(bar)[XB_TMO], 1u); break; } } } } while (0)

struct XcdBarrier {
    unsigned* bar; unsigned x;
    volatile LAS unsigned* st;
};

__device__ __forceinline__ XcdBarrier xcd_barrier_post(unsigned* bar, volatile LAS unsigned* st) {
    XcdBarrier b; b.bar = bar; b.x = xb_xcc_id(); b.st = st;
    if (threadIdx.x == 0) (void)xb_add(&bar[XB_XCNT(b.x)], 1u);
    return b;
}
__device__ __forceinline__ void xcd_barrier_complete(unsigned* bar, unsigned x, unsigned& nloc, unsigned& nx) {
    const unsigned G = gridDim.x * gridDim.y * gridDim.z;
    unsigned sum, cnt, mine, sp = 0u;
    for (;;) {
        sum = 0u; cnt = 0u; mine = 0u;
#pragma unroll
        for (unsigned j = 0; j < 16; ++j) { const unsigned c = xb_ld(&bar[XB_XCNT(j)]); sum += c; cnt += (c > 0u) ? 1u : 0u; mine = (j == x) ? c : mine; }
        if (sum == G) break;
        __builtin_amdgcn_s_sleep(1);
        if ((++sp & 255u) == 0u) { if (xb_ld(&bar[XB_TMO])) break; if (sp > XB_SPIN_CAP) { atomicAdd(&bar[XB_TMO], 1u); break; } }
    }
    nloc = mine > 0u ? mine : 1u; nx = cnt > 0u ? cnt : 1u;
}

__device__ __forceinline__ void xcd_barrier(const XcdBarrier& b) {
    asm volatile("s_waitcnt vmcnt(0)" ::: "memory");
    __syncthreads();
    if (threadIdx.x == 0) {
        unsigned* bar = b.bar;
        __builtin_amdgcn_s_waitcnt(0);
        unsigned nloc = b.st[0], nx = b.st[1];
        if (nloc == 0u) { xcd_barrier_complete(bar, b.x, nloc, nx); b.st[0] = nloc; b.st[1] = nx; }
        const unsigned old = xb_add(&bar[XB_XSUB(b.x)], 1u);
        const unsigned gen = old / nloc;
        if (old + 1u == (gen + 1u) * nloc) {
            __builtin_amdgcn_fence(__ATOMIC_RELEASE, "agent");
            asm volatile("s_waitcnt vmcnt(0)" ::: "memory");
            const unsigned og = xb_add(&bar[XB_TOP], 1u);
            const unsigned tg = og / nx;
            if (og + 1u == (tg + 1u) * nx) xb_add(&bar[XB_TOPGEN], 1u);
            else XB_SPIN(xb_ld(&bar[XB_TOPGEN]) == tg, bar);
            __builtin_amdgcn_fence(__ATOMIC_ACQUIRE, "agent");
            xb_add(&bar[XB_XGEN(b.x)], 1u);
            asm volatile("s_waitcnt vmcnt(0)" ::: "memory");
        } else {
            XB_SPIN(xb_ld(&bar[XB_XGEN(b.x)]) == gen, bar);
            __builtin_amdgcn_fence(__ATOMIC_ACQUIRE, "agent");
            asm volatile("s_waitcnt vmcnt(0)" ::: "memory");
        }
    }
    __syncthreads();
}

#ifndef MK_MASK
#define MK_MASK 0xffff
#endif
#ifndef MK_DUP
#define MK_DUP 0
#endif
#ifndef MK_DUPATT
#define MK_DUPATT 0
#endif
#ifndef MK_XBAR
#define MK_XBAR 0
#endif
#ifndef MK_STAGGER
#define MK_STAGGER 0
#endif
#ifndef MK_DUPNULL
#define MK_DUPNULL 0
#endif
constexpr int NSUB = 9, NSTEPS = 1 + NCH * DEPTH * NSUB + 1;
#ifndef MK_WGM_Z
#define MK_WGM_Z 4
#endif
#ifndef MK_WGM_UP
#define MK_WGM_UP 8
#endif
#ifndef MK_WGM_S
#define MK_WGM_S 4
#endif
__device__ __forceinline__ void fill_rs(LAS float* tab, const float* part, int M, int N, int GX, int BX, int tid_in) {
    int tid = tid_in; asm volatile("" : "+v"(tid));
    pg8::StaticOrder S; S.init(M, N, GX, BX, N == INW ? MK_WGM_Z : (N == 2 * DFF ? MK_WGM_UP : MK_WGM_S));
    int nu = 0; { pg8::Unit u; while (nu < RS_UNITS && S.next(nu, u)) ++nu; }
#pragma unroll
    for (int j = 0; j < RS_UNITS / 2; ++j) { const int i = 2 * j + (tid >> 8); if (i < nu) { pg8::Unit u; S.next(i, u); tab[i * 256 + (tid & 255)] = rowscale(part, u.pm * 256 + (tid & 255)); } }
    __syncthreads();
}
#define GEMM_CALL(EPI, g, E) do { pg8::StaticOrder S_; S_.init((g).M, (g).N, GX, BX, (g).N == INW ? MK_WGM_Z : ((g).N == 2 * DFF ? MK_WGM_UP : MK_WGM_S)); pg8::gemm_phase<EPI, pg8::StaticOrder, true, true>(lds, g, S_, E, tidv); } while (0)
__device__ __forceinline__ int make_tid(int wid0) { int l; asm volatile("v_mbcnt_lo_u32_b32 %0, -1, 0\n\tv_mbcnt_hi_u32_b32 %0, -1, %0" : "=v"(l)); return wid0 * 64 + l; }
__device__ __forceinline__ void run_step(LAS unsigned char* lds, int step, const int wid0) {
    const __attribute__((address_space(4))) Args* ap = (const __attribute__((address_space(4))) Args*)__builtin_amdgcn_kernarg_segment_ptr();
    long zero = 0; asm volatile("" : "+s"(zero), "+s"(ap));
    Args a;
#pragma unroll
    for (int i = 0; i < 18; ++i) a.in[i] = ap->in[i];
    a.out = ap->out; a.ws = ap->ws; a.lo = 0; a.hi = 0;
    const int wid0z = wid0 + (int)zero;
#define tidv make_tid(wid0z)
    const int GX = (int)gridDim.x + (int)zero, BX = (int)blockIdx.x + (int)zero;
    unsigned char* ws = a.ws;
    if (step == NSTEPS - 1) { if (MK_MASK & 1024) final_phase(a.out, (const bf16_t*)(ws + O_XB0), (const float*)(ws + O_SSA), a.in[17], tidv); return; }
    const int s0 = step - 1, c = s0 / (DEPTH * NSUB), l = (s0 / NSUB) % DEPTH, sub = s0 % NSUB;
    const size_t r0 = (size_t)c * MC;
    unsigned char* wl = ws + O_W + (size_t)l * SZ_WL;
    bf16_t* xb0 = (bf16_t*)(ws + O_XB0) + r0 * DM; bf16_t* xb1 = (bf16_t*)(ws + O_XB1); bf16_t* xb2 = (bf16_t*)(ws + O_XB2);
    float* ssa = (float*)(ws + O_SSA) + r0 * 16; float* ssb = (float*)(ws + O_SSB) + r0 * 16; float* ssc = (float*)(ws + O_SSC) + r0 * 16;
    if (sub == 0 && (MK_MASK & 1)) {
        pg8::Gemm g{xb0, (const bf16_t*)(wl + WO_IN), MC, INW, DM};
        fill_rs((LAS float*)(lds + LDS_RS), ssa, MC, INW, GX, BX, tidv);
#if MK_STAGGER
        if ((BX >> 3) & 1) { for (int i = 0; i < MK_STAGGER; ++i) __builtin_amdgcn_s_sleep(127); }
#endif
        EpiZ E{ssa, (const float*)(ws + O_ROPE), (bf16_t*)(ws + O_Q), (bf16_t*)(ws + O_UP), (const LAS float*)(lds + LDS_RS)};
        GEMM_CALL(EpiZ, g, E);
#if MK_DUPNULL & 1
        { EpiNull EN{(float*)(ws + O_BAR + 65536)}; GEMM_CALL(EpiNull, g, EN); }
#endif
    } else if (sub == 1 && (MK_MASK & 2)) {
        attn_phase(lds, (const bf16_t*)(ws + O_Q), (const bf16_t*)(ws + O_Q) + (size_t)MC * 1536, (const bf16_t*)(ws + O_Q) + (size_t)2 * MC * 1536, (bf16_t*)(ws + O_OG), (float*)(ws + O_LSE), tidv);
#if MK_DUPATT
        attn_phase(lds, (const bf16_t*)(ws + O_Q), (const bf16_t*)(ws + O_Q) + (size_t)MC * 1536, (const bf16_t*)(ws + O_Q) + (size_t)2 * MC * 1536, (bf16_t*)(ws + O_OG), (float*)(ws + O_LSE), tidv);
#endif
        pool_phase((const bf16_t*)(ws + O_UP), (bf16_t*)(ws + O_ATTN), tidv);
    } else if (sub == 2 && (MK_MASK & 4)) {
        merge_phase((const bf16_t*)(ws + O_OG), (const float*)(ws + O_LSE), (bf16_t*)(ws + O_ATTN), tidv);
    } else if (sub == 3 && (MK_MASK & 8)) {
        pg8::Gemm g{(const bf16_t*)(ws + O_ATTN), (const bf16_t*)(wl + WO_YA), MC, DM, 1536};
        EpiAB E{(const bf16_t*)(ws + O_UP) + (size_t)MC * 1024, (const bf16_t*)(ws + O_UP) + (size_t)2 * MC * 1024, (bf16_t*)(ws + O_MERGED)};
        GEMM_CALL(EpiAB, g, E);
    } else if (sub == 4 && (MK_MASK & 16)) {
        pg8::Gemm g{(const bf16_t*)(ws + O_MERGED), (const bf16_t*)(wl + WO_O), MC, DM, DM};
        EpiRes<0> E{xb0, xb1, ssb, nullptr, nullptr, nullptr};
        GEMM_CALL(EpiRes<0>, g, E);
    } else if (sub == 5 && (MK_MASK & 32)) {
        pg8::Gemm g{xb1, (const bf16_t*)(wl + WO_UP), MC, 2 * DFF, DM};
        fill_rs((LAS float*)(lds + LDS_RS), ssb, MC, 2 * DFF, GX, BX, tidv);
        EpiConv E{ssb, a.in[11] + (size_t)l * 3 * 2 * DFF, a.in[12] + (size_t)l * 2 * DFF, (bf16_t*)(ws + O_ACT), (float*)(ws + O_HB), (const LAS float*)(lds + LDS_RS), (LAS float*)(lds + LDS_CW)};
        GEMM_CALL(EpiConv, g, E);
#if MK_DUPNULL & 2
        { EpiNull EN{(float*)(ws + O_BAR + 65536)}; GEMM_CALL(EpiNull, g, EN); }
#endif
    } else if (sub == 6 && (MK_MASK & 64)) {
        fixup_phase((const float*)(ws + O_HB), a.in[11] + (size_t)l * 3 * 2 * DFF, a.in[12] + (size_t)l * 2 * DFF, (bf16_t*)(ws + O_ACT), tidv);
        { pg8::Gemm g{(const bf16_t*)(ws + O_PB) + ((size_t)l * MTOT + r0) * PLED, (const bf16_t*)(wl + WO_PLE), MC, DM, PLED};
          EpiF32 E{(bf16_t*)(ws + O_PW)};
          GEMM_CALL(EpiF32, g, E); }
    } else if (sub == 7 && (MK_MASK & 128)) {
        { pg8::Gemm g{(const bf16_t*)(ws + O_ACT), (const bf16_t*)(wl + WO_DN), MC, DM, DFF};
          EpiRes<0> E{xb1, xb2, ssc, nullptr, nullptr, nullptr};
          GEMM_CALL(EpiRes<0>, g, E); }
    } else if (MK_MASK & 256) {
        pg8::Gemm g{xb2, (const bf16_t*)(wl + WO_PG), MC, DM, DM};
        fill_rs((LAS float*)(lds + LDS_RS), ssc, MC, DM, GX, BX, tidv);
        EpiRes<1> E{xb2, xb0, ssa, (const bf16_t*)(ws + O_PW), ssc, (const LAS float*)(lds + LDS_RS)};
        GEMM_CALL(EpiRes<1>, g, E);
    }
}

#undef tidv
template <bool COOP>
__global__ void __launch_bounds__(NTHREADS, 2) fwd(Args a) {
    extern __shared__ __attribute__((aligned(16))) unsigned char lds_raw[];
    LAS unsigned char* lds = (LAS unsigned char*)lds_raw;
    const int wid0 = __builtin_amdgcn_readfirstlane((int)threadIdx.x >> 6);
    XcdBarrier bar; bar.bar = nullptr; bar.x = 0; bar.st = nullptr;
    if constexpr (COOP) {
        volatile LAS unsigned* st = (volatile LAS unsigned*)(lds + 131072);
        if (threadIdx.x < 2) st[threadIdx.x] = 0u;
        __syncthreads();
        bar = xcd_barrier_post((unsigned*)(a.ws + O_BAR), st);
    }
    int s = a.lo;
    if (s == 0 && s < a.hi) { if (MK_MASK & 512) prologue(a, lds, make_tid(wid0));
#if MK_DUP & 512
        prologue(a, lds, make_tid(wid0));
#endif
 ++s; if constexpr (COOP) { if (s < a.hi) cg::this_grid().sync(); } }
    for (; s < a.hi; ++s) {
        run_step(lds, s, wid0);
#if MK_DUP
        if (s < NSTEPS - 1 && ((MK_DUP >> ((s - 1) % NSUB)) & 1)) run_step(lds, s, wid0);
#endif
        if constexpr (COOP) { if (s + 1 < a.hi) xcd_barrier(bar); }
#if MK_XBAR
        if constexpr (COOP) { if (s + 1 < a.hi) xcd_barrier(bar); }
#endif
    }
}

extern "C" void kernel_launch(void* const* d_in, const int* in_sizes, int n_in, void* d_out, int out_size, void* d_ws, size_t ws_size, hipStream_t stream) {
    static int grid = 0;
    if (grid == 0) {
        if (n_in != 18 || in_sizes[0] != MTOT * DM || out_size != MTOT * DM || ws_size < O_END) {
            fprintf(stderr, "kernel_launch: unexpected shapes or workspace (n_in %d, in0 %d, out %d, ws %zu, need %zu); nothing launched\n", n_in, n_in > 0 ? in_sizes[0] : -1, out_size, ws_size, (size_t)O_END);
            grid = -1; return; }
        int dev = 0, cus = 0, per_cu = 0;
        if (hipGetDevice(&dev) != hipSuccess || hipDeviceGetAttribute(&cus, hipDeviceAttributeMultiprocessorCount, dev) != hipSuccess) { grid = -1; return; }
#if MK_SINGLE
#define FWD_K fwd<true>
#else
#define FWD_K fwd<false>
#endif
        if (hipFuncSetAttribute((const void*)FWD_K, hipFuncAttributeMaxDynamicSharedMemorySize, LDS_BYTES) != hipSuccess) { fprintf(stderr, "kernel_launch: hipFuncSetAttribute failed\n"); grid = -1; return; }
        if (hipOccupancyMaxActiveBlocksPerMultiprocessor(&per_cu, (const void*)FWD_K, NTHREADS, LDS_BYTES) != hipSuccess || per_cu < 1) { fprintf(stderr, "kernel_launch: occupancy query says %d blocks per CU\n", per_cu); per_cu = 1; }
        (void)hipGetLastError();
        grid = cus * per_cu;
    }
    if (grid < 0) return;
    if (hipMemsetAsync((char*)d_ws + O_BAR, 0, XCD_BAR_WORDS * 4, stream) != hipSuccess) { fprintf(stderr, "kernel_launch: memset of the barrier words failed\n"); return; }
    Args a{};
    for (int i = 0; i < 18; ++i) a.in[i] = (const float*)d_in[i];
    a.out = (float*)d_out; a.ws = (unsigned char*)d_ws;
#if MK_SINGLE
    a.lo = 0; a.hi = NSTEPS;
    void* args[] = {&a};
    const hipError_t e = hipLaunchCooperativeKernel((const void*)fwd<true>, dim3(grid), dim3(NTHREADS), args, LDS_BYTES, stream);
    if (e != hipSuccess) fprintf(stderr, "kernel_launch: cooperative launch failed: %s (grid %d)\n", hipGetErrorString(e), grid);
#else
    for (int s = 0; s < NSTEPS; ++s) { a.lo = s; a.hi = s + 1; hipLaunchKernelGGL(fwd<false>, dim3(grid), dim3(NTHREADS), LDS_BYTES, stream, a); }
#endif
}
```

```cpp
#include <hip/hip_runtime.h>
#include <hip/hip_cooperative_groups.h>
#include <cstdio>
#include <cstdint>
#include <cmath>
namespace cg = cooperative_groups;

namespace pg8 {
#define PG8_LAS __attribute__((address_space(3)))
typedef unsigned short bf16_t;
typedef short bf16x8 __attribute__((ext_vector_type(8)));
typedef float f32x4 __attribute__((ext_vector_type(4)));
typedef unsigned u32x4 __attribute__((ext_vector_type(4)));
constexpr int BM = 256, BK = 64, HALF = 128, HTB = HALF * BK * 2  , STAGE_BYTES = 8 * HTB, NXCD = 8, WGM = 8;

__host__ __device__ __forceinline__ int lds_byte(int r, int c) { const int st = (r >> 4) * 2 + (c >> 5), rr = r & 15, cc = c & 31, ob = rr * 64 + cc * 2; return st * 1024 + (ob ^ (((ob >> 9) & 1) << 5)); }
__host__ __device__ __forceinline__ void stage_rc(int b, int& R, int& C) { const int st = b / 1024, sb = b % 1024, swz = sb ^ (((sb >> 9) & 1) << 5); R = (st >> 1) * 16 + swz / 64; C = (st & 1) * 32 + (swz % 64) / 2; }
__host__ __device__ __forceinline__ int perm32(int rho) { const int n = rho >> 4, i = rho & 15; return 8 * (i >> 2) + 4 * n + (i & 3); }

struct Unit { int pm, pn, ui; };
struct Gemm { const bf16_t* A; const bf16_t* Bt; int M, N, K; };

struct StaticOrder {
    int nM, nN, nwg, G, c, wgm;
    __host__ __device__ void init(int M, int N, int G_, int c_, int wgm_ = WGM) { nM = M / BM; nN = N / BM; nwg = nM * nN; G = G_; c = c_; wgm = wgm_; }
    __host__ __device__ bool next(int i, Unit& u) const {
        const int L = i * G + c; if (L >= nwg) return false;
        int wgid = L; { const int q = nwg / NXCD, r = nwg % NXCD, xcd = wgid % NXCD, off = wgid / NXCD; wgid = (xcd < r ? xcd * (q + 1) : r * (q + 1) + (xcd - r) * q) + off; }
        const int nig = wgm * nN, gid = wgid / nig, fm = gid * wgm, gsz = (nM - fm) < wgm ? (nM - fm) : wgm;
        u.pm = fm + ((wgid % nig) % gsz); u.pn = (wgid % nig) / gsz; u.ui = i; return true;
    }
    __device__ __forceinline__ void a_ready(const Unit&) const {}
    __device__ __forceinline__ void done(const Unit&) const {}
};

__device__ __forceinline__ unsigned cvt_pk_bf16(float lo, float hi) { unsigned r; asm volatile("v_cvt_pk_bf16_f32 %0, %1, %2" : "=v"(r) : "v"(lo), "v"(hi)); return r; }
typedef float f32x2 __attribute__((ext_vector_type(2)));

template <class Epi, class Sched, bool ALIGN_EPI = false, bool SP2 = false>
__device__ __forceinline__ void gemm_phase(PG8_LAS unsigned char* lds, const Gemm g, const Sched& S, const Epi& E, const int tid_in) {
    int tid_ = tid_in; asm volatile("" : "+v"(tid_));
    const int tid = tid_, wid = __builtin_amdgcn_readfirstlane(tid >> 6), lane = tid & 63, wr = wid >> 2, wc = wid & 3, fr = lane & 15, fq = lane >> 4;
    const int K = g.K, nt = K / BK;
    unsigned voffA[2], voffB[2];
#pragma unroll
    for (int i = 0; i < 2; ++i) { int R, C; stage_rc(tid * 16 + i * 8192, R, C); const int Rb = Epi::PERM ? ((R & ~31) + perm32(R & 31)) : R;
        voffA[i] = (unsigned)(R * K + C) * 2u; voffB[i] = (unsigned)(Rb * K + C) * 2u; }
    const size_t kstep = (size_t)(BK * 2);
    const size_t hstep = (size_t)HALF * K * 2;
    const size_t tstep = 2 * hstep;
    const unsigned ldsw = (unsigned)wid * 1024u;
    const int aoff = lds_byte(wr * 64 + fr, fq * 8), boff = lds_byte(wc * 32 + fr, fq * 8);
#define PG8_SA(b, h) (((b) * 2 + (h)) * HTB)
#define PG8_SB(b, h) ((4 + (b) * 2 + (h)) * HTB)
#define PG8_STAGE(bufoff, gbase, voff) do { const char* gb_ = (const char*)(gbase); asm volatile("" : "+s"(gb_));     \
        _Pragma("unroll") for (int _i = 0; _i < 2; ++_i) \
        __builtin_amdgcn_global_load_lds((const unsigned*)(gb_ + (voff)[_i]), (PG8_LAS unsigned*)(lds + (bufoff) + ldsw + _i * 8192), 16, 0, 0); } while (0)
#define PG8_LDA(dst, b, h) do { _Pragma("unroll") for (int m = 0; m < 4; ++m) _Pragma("unroll") for (int k = 0; k < 2; ++k) dst[m][k] = *(const PG8_LAS bf16x8*)(lds + PG8_SA(b, h) + aoff + m * 2048 + k * 1024); } while (0)
#define PG8_LDB(dst, b, h) do { _Pragma("unroll") for (int n = 0; n < 2; ++n) _Pragma("unroll") for (int k = 0; k < 2; ++k) dst[n][k] = *(const PG8_LAS bf16x8*)(lds + PG8_SB(b, h) + boff + n * 2048 + k * 1024); } while (0)
#define PG8_MMA(ai, bj, At, Bt) do { __builtin_amdgcn_s_setprio(1); _Pragma("unroll") for (int m = 0; m < 4; ++m) _Pragma("unroll") for (int n = 0; n < 2; ++n) _Pragma("unroll") for (int k = 0; k < 2; ++k) \
        acc[ai][bj][m][n] = __builtin_amdgcn_mfma_f32_16x16x32_bf16(Bt[n][k], At[m][k], acc[ai][bj][m][n], 0, 0, 0); __builtin_amdgcn_s_setprio(0); } while (0)
#define PG8_WAIT_V(n) asm volatile("s_waitcnt vmcnt(" #n ")" ::: "memory")
#define PG8_WAIT_L(n) asm volatile("s_waitcnt lgkmcnt(" #n ")" ::: "memory")
#define PG8_BAR __builtin_amdgcn_s_barrier()
#define PG8_SCHED __builtin_amdgcn_sched_barrier(0)
    Unit cur, nxt; int ui = 0;
    if (!S.next(0, cur)) return;
    f32x4 acc[2][2][4][2];
#pragma unroll
    for (int a = 0; a < 2; ++a)
#pragma unroll
        for (int b = 0; b < 2; ++b)
#pragma unroll
            for (int m = 0; m < 4; ++m)
#pragma unroll
                for (int n = 0; n < 2; ++n) acc[a][b][m][n] = (f32x4){0.f, 0.f, 0.f, 0.f};
    bf16x8 At[4][2], B0[2][2], B1[2][2];
    const char* cA = (const char*)g.A + (size_t)cur.pm * tstep; const char* cB = (const char*)g.Bt + (size_t)cur.pn * tstep;
    S.a_ready(cur);
    if constexpr (SP2) {
        PG8_STAGE(PG8_SB(0, 0), cB, voffB); PG8_STAGE(PG8_SB(0, 1), cB + hstep, voffB); PG8_STAGE(PG8_SA(0, 0), cA, voffA); PG8_STAGE(PG8_SA(0, 1), cA + hstep, voffA);
        if (wr == 1) PG8_BAR;
        PG8_WAIT_V(2); PG8_BAR;
        PG8_STAGE(PG8_SB(1, 0), cB + kstep, voffB); PG8_STAGE(PG8_SA(1, 0), cA + kstep, voffA); PG8_STAGE(PG8_SB(1, 1), cB + hstep + kstep, voffB);
        PG8_WAIT_V(6); PG8_BAR;
    } else {
        PG8_STAGE(PG8_SB(0, 0), cB, voffB); PG8_STAGE(PG8_SA(0, 0), cA, voffA); PG8_STAGE(PG8_SB(0, 1), cB + hstep, voffB); PG8_STAGE(PG8_SA(0, 1), cA + hstep, voffA);
        if (wr == 1) PG8_BAR;
        PG8_WAIT_V(4); PG8_BAR;
        PG8_STAGE(PG8_SB(1, 0), cB + kstep, voffB); PG8_STAGE(PG8_SA(1, 0), cA + kstep, voffA); PG8_STAGE(PG8_SB(1, 1), cB + hstep + kstep, voffB);
        PG8_WAIT_V(6); PG8_BAR;
    }
    for (;;) {
        const bool has_next = S.next(ui + 1, nxt);
        const char* nA = has_next ? (const char*)g.A + (size_t)nxt.pm * tstep : cA; const char* nB = has_next ? (const char*)g.Bt + (size_t)nxt.pn * tstep : cB;
        for (int t = 0; t < nt; t += 2) {
            if constexpr (Epi::HOOKT >= 0) { if (t == Epi::HOOKT) E.hook(acc, cur, wr, wc, fr, fq); }
            const bool last = (t == nt - 2);
            const char* a1 = cA + (size_t)(t + 1) * kstep;
            const char* a2 = last ? nA : cA + (size_t)(t + 2) * kstep; const char* b2 = last ? nB : cB + (size_t)(t + 2) * kstep;
            const char* a3 = a2 + kstep; const char* b3 = b2 + kstep;
            if (last && has_next) S.a_ready(nxt);
            if constexpr (SP2) {
            PG8_LDB(B0, 0, 0); PG8_LDB(B1, 0, 1); PG8_SCHED; PG8_LDA(At, 0, 0); PG8_STAGE(PG8_SA(1, 1), a1 + hstep, voffA);
            PG8_WAIT_V(8); PG8_WAIT_L(0); PG8_BAR; PG8_MMA(0, 0, At, B0); PG8_MMA(0, 1, At, B1); PG8_BAR; PG8_SCHED;
            PG8_LDA(At, 0, 1); PG8_STAGE(PG8_SB(0, 0), b2, voffB); PG8_STAGE(PG8_SB(0, 1), b2 + hstep, voffB); PG8_STAGE(PG8_SA(0, 0), a2, voffA);
            PG8_WAIT_V(8); PG8_WAIT_L(0); PG8_BAR; PG8_MMA(1, 0, At, B0); PG8_MMA(1, 1, At, B1); PG8_BAR; PG8_SCHED;
            PG8_LDB(B0, 1, 0); PG8_LDB(B1, 1, 1); PG8_SCHED; PG8_LDA(At, 1, 0); PG8_STAGE(PG8_SA(0, 1), a2 + hstep, voffA);
            PG8_WAIT_V(8); PG8_WAIT_L(0); PG8_BAR; PG8_MMA(0, 0, At, B0); PG8_MMA(0, 1, At, B1); PG8_BAR; PG8_SCHED;
            PG8_LDA(At, 1, 1); PG8_STAGE(PG8_SB(1, 0), b3, voffB); PG8_STAGE(PG8_SB(1, 1), b3 + hstep, voffB); PG8_STAGE(PG8_SA(1, 0), a3, voffA);
            PG8_WAIT_V(8); PG8_WAIT_L(0); PG8_BAR; PG8_MMA(1, 0, At, B0); PG8_MMA(1, 1, At, B1); PG8_BAR; PG8_SCHED;
            } else {
            PG8_LDB(B0, 0, 0); PG8_SCHED; PG8_LDA(At, 0, 0); PG8_STAGE(PG8_SA(1, 1), a1 + hstep, voffA);
            PG8_WAIT_L(8); PG8_BAR; PG8_WAIT_L(0); PG8_MMA(0, 0, At, B0); PG8_BAR; PG8_SCHED;
            PG8_LDB(B1, 0, 1); PG8_STAGE(PG8_SB(0, 0), b2, voffB);
            PG8_BAR; PG8_WAIT_L(0); PG8_MMA(0, 1, At, B1); PG8_BAR;
            PG8_LDA(At, 0, 1); PG8_STAGE(PG8_SA(0, 0), a2, voffA);
            PG8_BAR; PG8_WAIT_L(0); PG8_MMA(1, 0, At, B0); PG8_BAR; PG8_SCHED;
            PG8_STAGE(PG8_SB(0, 1), b2 + hstep, voffB);
            PG8_WAIT_V(6); PG8_BAR; PG8_MMA(1, 1, At, B1); PG8_BAR;
            PG8_LDB(B0, 1, 0); PG8_SCHED; PG8_LDA(At, 1, 0); PG8_STAGE(PG8_SA(0, 1), a2 + hstep, voffA);
            PG8_WAIT_L(8); PG8_BAR; PG8_WAIT_L(0); PG8_MMA(0, 0, At, B0); PG8_BAR; PG8_SCHED;
            PG8_LDB(B1, 1, 1); PG8_STAGE(PG8_SB(1, 0), b3, voffB);
            PG8_BAR; PG8_WAIT_L(0); PG8_MMA(0, 1, At, B1); PG8_BAR;
            PG8_LDA(At, 1, 1); PG8_STAGE(PG8_SA(1, 0), a3, voffA);
            PG8_BAR; PG8_WAIT_L(0); PG8_MMA(1, 0, At, B0); PG8_BAR; PG8_SCHED;
            PG8_STAGE(PG8_SB(1, 1), b3 + hstep, voffB);
            PG8_WAIT_V(6); PG8_BAR; PG8_MMA(1, 1, At, B1); PG8_BAR;
            }
        }
        if constexpr (ALIGN_EPI) { if (wr == 0) PG8_BAR; }
        if constexpr (!Epi::AFTER_DRAIN) { E(acc, cur, wr, wc, fr, fq); S.done(cur); }
        if (!has_next) break;
#pragma unroll
        for (int a = 0; a < 2; ++a)
#pragma unroll
            for (int b = 0; b < 2; ++b)
#pragma unroll
                for (int m = 0; m < 4; ++m)
#pragma unroll
                    for (int n = 0; n < 2; ++n) acc[a][b][m][n] = (f32x4){0.f, 0.f, 0.f, 0.f};
        cur = nxt; cA = nA; cB = nB; ++ui;
        if constexpr (ALIGN_EPI) { if (wr == 1) PG8_BAR; }
    }
    PG8_WAIT_V(0);
    if constexpr (!ALIGN_EPI) { if (wr == 0) PG8_BAR; }
    PG8_BAR;
    if constexpr (Epi::AFTER_DRAIN) { E.fused(acc, cur, wr, wc, fr, fq, lds, wid, lane); S.done(cur); }
#undef PG8_SA
#undef PG8_SB
#undef PG8_STAGE
#undef PG8_LDA
#undef PG8_LDB
#undef PG8_MMA
#undef PG8_WAIT_V
#undef PG8_WAIT_L
#undef PG8_BAR
#undef PG8_SCHED
}
}

using pg8::bf16_t; using pg8::bf16x8; using pg8::f32x4; using pg8::u32x4; using pg8::cvt_pk_bf16;
#define LAS __attribute__((address_space(3)))
typedef short v4i16_t __attribute__((ext_vector_type(4)));
typedef unsigned u32x2 __attribute__((ext_vector_type(2)));

constexpr int DM = 1024, SEQ = 2048, BATCH = 32, MTOT = BATCH * SEQ, INW = 7680, DFF = 2816, PLED = 256, DEPTH = 2;
#ifndef MK_NCH
#define MK_NCH 2
#endif
constexpr int NCH = MK_NCH, MC = MTOT / NCH, NBC = BATCH / NCH;
constexpr float RMS_EPS = 1e-6f;
constexpr float QSCALE = 0.08838834764831845f * 1.4426950408889634f;
constexpr int NTHREADS = 512;
constexpr int RS_UNITS = 20;
constexpr int LDS_RS = 131072 + 1024;
constexpr int LDS_CW = LDS_RS + RS_UNITS * 1024;
constexpr int LDS_BYTES = LDS_CW + 4096;
static_assert(LDS_BYTES <= 163840, "LDS map");
#ifndef MK_SINGLE
#define MK_SINGLE 1
#endif

constexpr size_t al1m(size_t x) { return (x + 1048575) & ~(size_t)1048575; }
constexpr size_t SZ_WIN = (size_t)INW * DM * 2, SZ_WYA = (size_t)1024 * 512 * 2, SZ_WB = (size_t)1024 * 1024 * 2, SZ_WO = SZ_WB, SZ_WUP = (size_t)2 * DFF * DM * 2,
                 SZ_WDN = (size_t)DM * DFF * 2, SZ_WPLE = (size_t)1024 * 256 * 2, SZ_WPG = SZ_WB;
constexpr size_t WO_IN = 0, WO_YA = WO_IN + SZ_WIN, WO_B = WO_YA + SZ_WYA, WO_O = WO_B + SZ_WB, WO_UP = WO_O + SZ_WO, WO_DN = WO_UP + SZ_WUP, WO_PLE = WO_DN + SZ_WDN,
                 WO_PG = WO_PLE + SZ_WPLE, SZ_WL = WO_PG + SZ_WPG;
constexpr size_t O_BAR = 524288;
constexpr size_t O_ROPE = 0;
constexpr size_t O_SSA = (size_t)1 << 20, O_SSB = O_SSA + (size_t)MTOT * 64, O_SSC = O_SSB + (size_t)MTOT * 64;
constexpr size_t O_W = al1m(O_SSC + (size_t)MTOT * 64);
constexpr size_t O_XB0 = al1m(O_W + 2 * SZ_WL);
constexpr size_t O_PB = O_XB0 + (size_t)MTOT * DM * 2;
constexpr size_t O_Q = O_PB + (size_t)2 * MTOT * PLED * 2;
constexpr size_t O_ACT = O_Q;
constexpr size_t O_T1 = O_Q + (size_t)2 * MC * 1536 * 2;
constexpr size_t O_UP = O_Q + (size_t)3 * MC * 1536 * 2;
constexpr size_t O_PW = O_UP;
constexpr size_t O_HB = O_UP + (size_t)MC * 1024 * 2;
constexpr size_t O_OG = O_UP + (size_t)3 * MC * 1024 * 2;
constexpr size_t O_MERGED = O_OG;
constexpr size_t O_XB2 = O_OG;
constexpr size_t O_LSE = O_OG + (size_t)3 * MC * 512 * 2;
constexpr size_t O_ATTN = O_LSE + (size_t)3 * MC * 4 * 4;
constexpr size_t O_POOLED = O_ATTN + (size_t)MC * 512 * 2;
constexpr size_t O_XB1 = O_POOLED;
constexpr size_t O_END = O_POOLED + (size_t)MC * 1024 * 2;
static_assert((size_t)(MC / 64) * 4 * 2 * DFF * 4 <= (size_t)MC * 1024 * 2, "halo buffer fits in the gate_a region");
static_assert((size_t)MC * DFF * 2 <= (size_t)2 * MC * 1536 * 2, "act fits in the q,k region");
static_assert(O_END <= ((size_t)1 << 30), "workspace map fits in 1 GiB");

struct Args { const float* in[18]; float* out; unsigned char* ws; int lo, hi; };
__device__ __forceinline__ double inv_freq(int j) {
    const double lt = -0.8201018507344862;
    double r = 1.0;
    if (j & 1) r *= 0.4403666026717805; if (j & 2) r *= 0.1939227447486858; if (j & 4) r *= 0.03760603093086394; if (j & 8) r *= 0.0014142135623730955;
    (void)lt; return r;
}

__device__ __forceinline__ float sigm(float x) { return __builtin_amdgcn_rcpf(1.f + __builtin_amdgcn_exp2f(-1.4426950408889634f * x)); }
__device__ __forceinline__ float rowscale(const float* part, int row) {
    const f32x4* p = (const f32x4*)(part + (size_t)row * 16);
    const f32x4 a = p[0], b = p[1], c = p[2], d = p[3];
    const float s = (((a[0] + a[1]) + (a[2] + a[3])) + ((b[0] + b[1]) + (b[2] + b[3]))) + (((c[0] + c[1]) + (c[2] + c[3])) + ((d[0] + d[1]) + (d[2] + d[3])));
    return __builtin_amdgcn_rsqf(s * (1.f / 1024.f) + RMS_EPS);
}
__device__ __forceinline__ u32x4 pack8(const f32x4 a, const f32x4 b) { u32x4 w; w.x = cvt_pk_bf16(a[0], a[1]); w.y = cvt_pk_bf16(a[2], a[3]); w.z = cvt_pk_bf16(b[0], b[1]); w.w = cvt_pk_bf16(b[2], b[3]); return w; }
__device__ __forceinline__ void unpack8(const u32x4 w, f32x4& a, f32x4& b) {
    a[0] = __uint_as_float(w.x << 16); a[1] = __uint_as_float(w.x & 0xffff0000u); a[2] = __uint_as_float(w.y << 16); a[3] = __uint_as_float(w.y & 0xffff0000u);
    b[0] = __uint_as_float(w.z << 16); b[1] = __uint_as_float(w.z & 0xffff0000u); b[2] = __uint_as_float(w.w << 16); b[3] = __uint_as_float(w.w & 0xffff0000u);
}
__device__ __forceinline__ float xsum16(float v) { auto r = __builtin_amdgcn_permlane16_swap(__float_as_uint(v), __float_as_uint(v), false, false); return __uint_as_float(r[0]) + __uint_as_float(r[1]); }
__device__ __forceinline__ float xsum32(float v) { auto r = __builtin_amdgcn_permlane32_swap(__float_as_uint(v), __float_as_uint(v), false, false); return __uint_as_float(r[0]) + __uint_as_float(r[1]); }
__device__ __forceinline__ float xmax16(float v) { auto r = __builtin_amdgcn_permlane16_swap(__float_as_uint(v), __float_as_uint(v), false, false); return fmaxf(__uint_as_float(r[0]), __uint_as_float(r[1])); }
__device__ __forceinline__ float xmax32(float v) { auto r = __builtin_amdgcn_permlane32_swap(__float_as_uint(v), __float_as_uint(v), false, false); return fmaxf(__uint_as_float(r[0]), __uint_as_float(r[1])); }
__device__ __forceinline__ float partner32(float v, bool lower) { auto r = __builtin_amdgcn_permlane32_swap(__float_as_uint(v), __float_as_uint(v), false, false); return __uint_as_float(lower ? r[1] : r[0]); }
#define LDS_WAIT() asm volatile("s_waitcnt lgkmcnt(0)" ::: "memory")

__device__ __forceinline__ void rowscale4(const float* part, int row0, float (&rs)[4]) {
    f32x4 p[4][4];
#pragma unroll
    for (int m = 0; m < 4; ++m) { const f32x4* q = (const f32x4*)(part + (size_t)(row0 + 16 * m) * 16);
#pragma unroll
        for (int j = 0; j < 4; ++j) p[m][j] = q[j]; }
#pragma unroll
    for (int m = 0; m < 4; ++m) {
        float s = 0.f;
#pragma unroll
        for (int j = 0; j < 4; ++j) s += (p[m][j][0] + p[m][j][1]) + (p[m][j][2] + p[m][j][3]);
        rs[m] = __builtin_amdgcn_rsqf(s * (1.f / 1024.f) + RMS_EPS);
    }
    asm volatile("" : "+v"(rs[0]), "+v"(rs[1]), "+v"(rs[2]), "+v"(rs[3]) :: "memory");
}
__device__ __forceinline__ void rs4(const LAS float* tab, const float* part, const pg8::Unit& u, int row0, float (&rs)[4]) {
    if (u.ui < RS_UNITS) {
#pragma unroll
        for (int m = 0; m < 4; ++m) rs[m] = tab[u.ui * 256 + ((row0 + 16 * m) & 255)];
    } else rowscale4(part, row0, rs);
}
struct EpiZ {
    static constexpr bool PERM = true, AFTER_DRAIN = false; static constexpr int HOOKT = -1;
    const float* part; const float* rope; bf16_t* qkv; bf16_t* ugg; const LAS float* rstab;
    template <bool ROT> __device__ __forceinline__ void qkv_half(const f32x4 (&acc)[2][2][4][2], const pg8::Unit& u, int ai, int wr, int wc, int fr, int fq, bf16_t* base, int g, int pp, float qs) const {
        const int sh = 2 * g, row0 = u.pm * 256 + ai * 128 + wr * 64 + fr;
        float rs[4]; rs4(rstab, part, u, row0, rs);
        f32x4 cs[4][2];
        if (ROT) {
#pragma unroll
            for (int m = 0; m < 4; ++m) { const int t = (row0 + 16 * m) & 2047; cs[m][0] = *(const f32x4*)(rope + t * 16 + 4 * fq); cs[m][1] = *(const f32x4*)(rope + 32768 + t * 16 + 4 * fq); }
        }
#pragma unroll
        for (int m = 0; m < 4; ++m) {
            const int row = row0 + 16 * m;
            const float rq = rs[m] * qs;
            const int t = row & 2047, b = row >> 11;
            const int pos = ((t & ((1 << sh) - 1)) << (11 - sh)) + (t >> sh);
#pragma unroll
            for (int bj = 0; bj < 2; ++bj) {
                const int hh = (pp & 1) * 2 + bj;
                f32x4 v0 = acc[ai][bj][m][0] * rq, v1 = acc[ai][bj][m][1] * rq;
                if (ROT) { const f32x4 a0 = v0, a1 = v1; v0 = a0 * cs[m][0] - a1 * cs[m][1]; v1 = a1 * cs[m][0] + a0 * cs[m][1]; }
                bf16_t* dst = base + ((size_t)(((b * 3 + g) * 4 + hh) * 2048 + pos)) * 128 + wc * 32 + 8 * fq;
                *(u32x4*)dst = pack8(v0, v1);
            }
        }
        asm volatile("" ::: "memory");
    }
    __device__ __forceinline__ void operator()(const f32x4 (&acc)[2][2][4][2], const pg8::Unit& u, int wr, int wc, int fr, int fq) const {
        const int pn = u.pn;
        if (pn < 18) {
            const int kind = pn / 6, pp = pn - kind * 6, g = pp >> 1;
            bf16_t* base = qkv + (size_t)kind * MC * 1536;
            const float qs = (kind == 0) ? QSCALE : 1.f;
            if ((kind < 2) && (wc == 0)) { qkv_half<true>(acc, u, 0, wr, wc, fr, fq, base, g, pp, qs); qkv_half<true>(acc, u, 1, wr, wc, fr, fq, base, g, pp, qs); }
            else { qkv_half<false>(acc, u, 0, wr, wc, fr, fq, base, g, pp, qs); qkv_half<false>(acc, u, 1, wr, wc, fr, fq, base, g, pp, qs); }
        } else {
            const int reg = (pn - 18) >> 2, cb = ((pn - 18) & 3) * 256;
            bf16_t* base = ugg + (size_t)reg * MC * 1024;
#pragma unroll
            for (int ai = 0; ai < 2; ++ai) {
                const int row0 = u.pm * 256 + ai * 128 + wr * 64 + fr;
                float rs[4]; rs4(rstab, part, u, row0, rs);
#pragma unroll
                for (int m = 0; m < 4; ++m)
#pragma unroll
                    for (int bj = 0; bj < 2; ++bj) {
                        bf16_t* dst = base + (size_t)(row0 + 16 * m) * 1024 + cb + bj * 128 + wc * 32 + 8 * fq;
                        *(u32x4*)dst = pack8(acc[ai][bj][m][0] * rs[m], acc[ai][bj][m][1] * rs[m]);
                    }
                asm volatile("" ::: "memory");
            }
        }
    }
};
struct EpiAB {
    static constexpr bool PERM = true, AFTER_DRAIN = false; static constexpr int HOOKT = 8;
    const bf16_t* ga; const bf16_t* gb; bf16_t* merged;
    __device__ __forceinline__ void hook(f32x4 (&acc)[2][2][4][2], const pg8::Unit& u, int wr, int wc, int fr_in, int fq) const {
        int fr = fr_in; asm volatile("" : "+v"(fr));
#pragma unroll
        for (int ai = 0; ai < 2; ++ai) {
                const size_t off0 = (size_t)(u.pm * 256 + ai * 128 + wr * 64 + fr) * 1024 + u.pn * 256 + wc * 32 + 8 * fq;
                u32x4 ain[4][2], bin[4][2];
#pragma unroll
                for (int mm = 0; mm < 4; ++mm)
#pragma unroll
                    for (int bj = 0; bj < 2; ++bj) { ain[mm][bj] = *(const u32x4*)(ga + off0 + (size_t)mm * 16384 + bj * 128); bin[mm][bj] = *(const u32x4*)(gb + off0 + (size_t)mm * 16384 + bj * 128); }
#pragma unroll
                for (int mm = 0; mm < 4; ++mm)
#pragma unroll
                    for (int bj = 0; bj < 2; ++bj) {
                        f32x4 a0, a1, b0, b1; unpack8(ain[mm][bj], a0, a1); unpack8(bin[mm][bj], b0, b1);
#pragma unroll
                        for (int e = 0; e < 4; ++e) {
                            const float ea = __builtin_amdgcn_exp2f(-1.4426950408889634f * a0[e]), eb = __builtin_amdgcn_exp2f(-1.4426950408889634f * fmaxf(b0[e], -30.f));
                            acc[ai][bj][mm][0][e] *= (1.f + eb) * __builtin_amdgcn_rcpf(1.f + ea);
                            const float fa = __builtin_amdgcn_exp2f(-1.4426950408889634f * a1[e]), fb = __builtin_amdgcn_exp2f(-1.4426950408889634f * fmaxf(b1[e], -30.f));
                            acc[ai][bj][mm][1][e] *= (1.f + fb) * __builtin_amdgcn_rcpf(1.f + fa);
                        }
                    }
                asm volatile("" ::: "memory");
        }
    }
    __device__ __forceinline__ void operator()(const f32x4 (&acc)[2][2][4][2], const pg8::Unit& u, int wr, int wc, int fr, int fq) const {
#pragma unroll
        for (int ai = 0; ai < 2; ++ai) {
            const size_t off0 = (size_t)(u.pm * 256 + ai * 128 + wr * 64 + fr) * 1024 + u.pn * 256 + wc * 32 + 8 * fq;
            u32x4 bin[4][2];
#pragma unroll
            for (int m = 0; m < 4; ++m)
#pragma unroll
                for (int bj = 0; bj < 2; ++bj) bin[m][bj] = *(const u32x4*)(gb + off0 + (size_t)m * 16384 + bj * 128);
#pragma unroll
            for (int m = 0; m < 4; ++m)
#pragma unroll
                for (int bj = 0; bj < 2; ++bj) {
                    f32x4 b0, b1; unpack8(bin[m][bj], b0, b1);
                    f32x4 v0 = acc[ai][bj][m][0], v1 = acc[ai][bj][m][1];
#pragma unroll
                    for (int e = 0; e < 4; ++e) { v0[e] *= sigm(fmaxf(b0[e], -30.f)); v1[e] *= sigm(fmaxf(b1[e], -30.f)); }
                    *(u32x4*)(merged + off0 + (size_t)m * 16384 + bj * 128) = pack8(v0, v1);
                }
            asm volatile("" ::: "memory");
        }
    }
};
template <int MODE> struct EpiRes {
    static constexpr bool PERM = true, AFTER_DRAIN = false; static constexpr int HOOKT = (MODE == 1) ? 4 : -1;
    const bf16_t* base; bf16_t* xb; float* part; bf16_t* pw; const float* partin; const LAS float* rstab; int ldb, ldo;
    __device__ __forceinline__ void hook(f32x4 (&acc)[2][2][4][2], const pg8::Unit& u, int wr, int wc, int fr_in, int fq) const {
        int fr = fr_in; asm volatile("" : "+v"(fr));
#pragma unroll
        for (int ai = 0; ai < 2; ++ai)
#pragma unroll
            for (int m = 0; m < 4; ++m)
#pragma unroll
                for (int bj = 0; bj < 2; ++bj) {
                    const size_t off = (size_t)(u.pm * 256 + ai * 128 + wr * 64 + m * 16 + fr) * 1024 + u.pn * 256 + bj * 128 + wc * 32 + 8 * fq;
                    *(u32x4*)(pw + off) = pack8(acc[ai][bj][m][0], acc[ai][bj][m][1]);
                    acc[ai][bj][m][0] = (f32x4){0.f, 0.f, 0.f, 0.f}; acc[ai][bj][m][1] = (f32x4){0.f, 0.f, 0.f, 0.f};
                }
        asm volatile("" ::: "memory");
    }
    __device__ __forceinline__ void operator()(const f32x4 (&acc)[2][2][4][2], const pg8::Unit& u, int wr, int wc, int fr, int fq) const {
#pragma unroll
        for (int ai = 0; ai < 2; ++ai) {
            const int row0 = u.pm * 256 + ai * 128 + wr * 64 + fr;
            const int colp = u.pn * 256 + wc * 32 + 8 * fq;
            const size_t offb = (size_t)row0 * ldb + colp, offo = (size_t)row0 * ldo + colp, offp = (size_t)row0 * 1024 + colp;
            float rs[4] = {1.f, 1.f, 1.f, 1.f};
            if (MODE == 1) rs4(rstab, partin, u, row0, rs);
            u32x4 bin[4][2], pin[4][2];
#pragma unroll
            for (int m = 0; m < 4; ++m)
#pragma unroll
                for (int bj = 0; bj < 2; ++bj) {
                    bin[m][bj] = *(const u32x4*)(base + offb + (size_t)m * 16 * ldb + bj * 128);
                    if (MODE == 1) pin[m][bj] = *(const u32x4*)(pw + offp + (size_t)m * 16384 + bj * 128);
                }
#pragma unroll
            for (int m = 0; m < 4; ++m) {
                float sq = 0.f;
#pragma unroll
                for (int bj = 0; bj < 2; ++bj) {
                    f32x4 v0, v1; unpack8(bin[m][bj], v0, v1);
                    f32x4 a0 = acc[ai][bj][m][0], a1 = acc[ai][bj][m][1];
                    if (MODE == 1) {
                        f32x4 p0, p1; unpack8(pin[m][bj], p0, p1);
#pragma unroll
                        for (int e = 0; e < 4; ++e) { a0[e] = p0[e] * sigm(rs[m] * a0[e]); a1[e] = p1[e] * sigm(rs[m] * a1[e]); }
                    }
                    v0 += a0; v1 += a1;
                    *(u32x4*)(xb + offo + (size_t)m * 16 * ldo + bj * 128) = pack8(v0, v1);
                    sq += ((v0[0] * v0[0] + v0[1] * v0[1]) + (v0[2] * v0[2] + v0[3] * v0[3])) + ((v1[0] * v1[0] + v1[1] * v1[1]) + (v1[2] * v1[2] + v1[3] * v1[3]));
                }
                sq = xsum16(sq); sq = xsum32(sq);
                if (fq == 0) part[(size_t)(row0 + 16 * m) * 16 + u.pn * 4 + wc] = sq;
            }
            asm volatile("" ::: "memory");
        }
    }
};
struct EpiF32 {
    static constexpr bool PERM = true, AFTER_DRAIN = false; static constexpr int HOOKT = -1;
    bf16_t* o;
    __device__ __forceinline__ void operator()(const f32x4 (&acc)[2][2][4][2], const pg8::Unit& u, int wr, int wc, int fr, int fq) const {
#pragma unroll
        for (int ai = 0; ai < 2; ++ai)
#pragma unroll
            for (int m = 0; m < 4; ++m) {
                const int row = u.pm * 256 + ai * 128 + wr * 64 + m * 16 + fr;
#pragma unroll
                for (int bj = 0; bj < 2; ++bj) {
                    const size_t off = (size_t)row * 1024 + u.pn * 256 + bj * 128 + wc * 32 + 8 * fq;
                    *(u32x4*)(o + off) = pack8(acc[ai][bj][m][0], acc[ai][bj][m][1]);
                }
            }
    }
};
template <int N> __device__ __forceinline__ float shift_rows(float cur, float prev) {
    const int t = __builtin_amdgcn_update_dpp(0, __float_as_int(prev), 0x120 + N, 0xf, 0xf, false);
    const int r = __builtin_amdgcn_update_dpp(t, __float_as_int(cur), 0x110 + N, 0xf, 0xf, false);
    return __int_as_float(r);
}
__device__ __forceinline__ float silu_mul(float g, float v) { return g * sigm(g) * v; }
struct EpiConv {
    static constexpr bool PERM = true, AFTER_DRAIN = false; static constexpr int HOOKT = -1;
    const float* part; const float* cw; const float* cb; bf16_t* act; float* hb; const LAS float* rstab; LAS float* cwtab;
    __device__ __forceinline__ void operator()(const f32x4 (&acc)[2][2][4][2], const pg8::Unit& u, int wr, int wc, int fr, int fq) const {
        const int cbase = u.pn * 128 + wc * 32 + 8 * fq, lc = wc * 32 + 8 * fq;
        {
            const int t = wr * 256 + wc * 64 + fq * 16 + fr;
            if (t < 256) { const int k = t >> 5, c4 = (t & 31) * 4, kk = k & 3;
                const float* src = (kk < 3 ? cw + (size_t)kk * 2 * DFF : cb) + (k >> 2) * DFF + u.pn * 128 + c4;
                const f32x4 v = *(const f32x4*)src;
                *(LAS f32x4*)(cwtab + k * 128 + c4) = v; }
            asm volatile("s_waitcnt vmcnt(0) lgkmcnt(0)" ::: "memory"); __builtin_amdgcn_s_barrier(); asm volatile("" ::: "memory");
        }
#pragma unroll
        for (int ai = 0; ai < 2; ++ai) {
            float rs[4]; rs4(rstab, part, u, u.pm * 256 + ai * 128 + wr * 64 + fr, rs);
            const int blk = u.pm * 4 + ai * 2 + wr;
#pragma unroll
            for (int n = 0; n < 2; ++n) {
                const int c0 = cbase + 4 * n;
                const LAS float* ct = cwtab + lc + 4 * n;
                const f32x4 w0g = *(const LAS f32x4*)(ct), w1g = *(const LAS f32x4*)(ct + 128), w2g = *(const LAS f32x4*)(ct + 256), bg = *(const LAS f32x4*)(ct + 384),
                            w0v = *(const LAS f32x4*)(ct + 512), w1v = *(const LAS f32x4*)(ct + 640), w2v = *(const LAS f32x4*)(ct + 768), bv = *(const LAS f32x4*)(ct + 896);
                f32x4 pg = {0.f, 0.f, 0.f, 0.f}, pv = pg;
#pragma unroll
                for (int m = 0; m < 4; ++m) {
                    const int row = u.pm * 256 + ai * 128 + wr * 64 + m * 16 + fr;
                    const f32x4 ug = acc[ai][0][m][n] * rs[m], uv = acc[ai][1][m][n] * rs[m];
                    if (m == 0) { if (fr < 2) { float* h = hb + ((size_t)blk * 4 + fr) * (2 * DFF) + c0; *(f32x4*)h = ug; *(f32x4*)(h + DFF) = uv; } }
                    if (m == 3) { if (fr >= 14) { float* h = hb + ((size_t)blk * 4 + (fr - 12)) * (2 * DFF) + c0; *(f32x4*)h = ug; *(f32x4*)(h + DFF) = uv; } }
                    f32x4 o;
#pragma unroll
                    for (int e = 0; e < 4; ++e) {
                        const float g1 = shift_rows<1>(ug[e], pg[e]), g2 = shift_rows<2>(ug[e], pg[e]);
                        const float v1 = shift_rows<1>(uv[e], pv[e]), v2 = shift_rows<2>(uv[e], pv[e]);
                        const float yg = bg[e] + w2g[e] * ug[e] + w1g[e] * g1 + w0g[e] * g2;
                        const float yv = bv[e] + w2v[e] * uv[e] + w1v[e] * v1 + w0v[e] * v2;
                        o[e] = silu_mul(yg, yv);
                    }
                    u32x2 w; w.x = cvt_pk_bf16(o[0], o[1]); w.y = cvt_pk_bf16(o[2], o[3]);
                    *(u32x2*)(act + (size_t)row * DFF + c0) = w;
                    pg = ug; pv = uv;
                    asm volatile("" ::: "memory");
                }
            }
        }
    }
};

__device__ __forceinline__ void tr_item(const float* W, int ldn, int K, const float* gain, bf16_t* WT, int k0, int ns0, int nd0, LAS float* scr, int lane, bool rperm = false) {
#pragma unroll 16
    for (int i = 0; i < 32; ++i) { const int kk = 2 * i + (lane >> 5); float v = W[(size_t)(k0 + kk) * ldn + ns0 + (lane & 31)]; if (gain) v *= gain[k0 + kk];
        const int c = lane & 31, pc = rperm ? (8 * ((c & 15) >> 2) + 4 * (c >> 4) + (c & 3)) : c;
        scr[kk * 33 + pc] = v; }
    LDS_WAIT();
    const int c = lane & 7;
#pragma unroll
    for (int j = 0; j < 4; ++j) { const int n = (lane >> 3) + 8 * j; const LAS float* s = scr + (8 * c) * 33 + n;
        u32x4 o; o.x = cvt_pk_bf16(s[0 * 33], s[1 * 33]); o.y = cvt_pk_bf16(s[2 * 33], s[3 * 33]); o.z = cvt_pk_bf16(s[4 * 33], s[5 * 33]); o.w = cvt_pk_bf16(s[6 * 33], s[7 * 33]);
        *(u32x4*)(WT + (size_t)(nd0 + n) * K + k0 + 8 * c) = o; }
    LDS_WAIT();
}
__device__ __forceinline__ float wave_sum(float v) {
#pragma unroll
    for (int o = 1; o < 64; o <<= 1) v += __shfl_xor(v, o);
    return v;
}
__device__ __forceinline__ void prologue(const Args& a, LAS unsigned char* lds, const int tid_in) {
    int tid_ = tid_in; asm volatile("" : "+v"(tid_));
    const int tid = tid_, lane = tid & 63, wid = tid >> 6;
    const int gw = blockIdx.x * 8 + wid, NGW = gridDim.x * 8;
    const int gt = blockIdx.x * NTHREADS + tid, NT = gridDim.x * NTHREADS;
    unsigned char* ws = a.ws;
    {
        LAS float* scr = (LAS float*)(lds + wid * 16384);
        constexpr int I_IN = 16 * 240, I_YA = 8 * 32, I_O = 16 * 32, I_UP = 16 * 176, I_DN = 44 * 32, I_PLE = 4 * 32, I_PG = 16 * 32;
        constexpr int I_L = I_IN + I_YA + I_O + I_UP + I_DN + I_PLE + I_PG;
        for (int it = gw; it < 2 * I_L; it += NGW) {
            const int l = it / I_L; int r = it - l * I_L;
            unsigned char* wl = ws + O_W + (size_t)l * SZ_WL;
            if (r < I_IN) { const int kb = r / 240, nb = r % 240; tr_item(a.in[3] + (size_t)l * DM * INW, INW, DM, a.in[2] + l * DM, (bf16_t*)(wl + WO_IN), kb * 64, nb * 32, nb * 32, scr, lane, (nb < 96) && ((nb & 3) == 0)); continue; } r -= I_IN;
            if (r < I_YA) { const int kb = r / 32, nb = r % 32; tr_item(a.in[4] + (size_t)l * 512 * DM, DM, 1536, nullptr, (bf16_t*)(wl + WO_YA), kb * 64, nb * 32, nb * 32, scr, lane); continue; } r -= I_YA;
            if (r < I_O) { const int kb = r / 32, nb = r % 32; tr_item(a.in[8] + (size_t)l * DM * DM, DM, DM, nullptr, (bf16_t*)(wl + WO_O), kb * 64, nb * 32, nb * 32, scr, lane); continue; } r -= I_O;
            if (r < I_UP) { const int kb = r / 176, nb = r % 176; const int nd0 = nb * 32, pn = nd0 >> 8, bj = (nd0 >> 7) & 1, cc = nd0 & 127;
                tr_item(a.in[10] + (size_t)l * DM * 2 * DFF, 2 * DFF, DM, a.in[9] + l * DM, (bf16_t*)(wl + WO_UP), kb * 64, bj * DFF + pn * 128 + cc, nd0, scr, lane); continue; } r -= I_UP;
            if (r < I_DN) { const int kb = r / 32, nb = r % 32; tr_item(a.in[13] + (size_t)l * DFF * DM, DM, DFF, nullptr, (bf16_t*)(wl + WO_DN), kb * 64, nb * 32, nb * 32, scr, lane); continue; } r -= I_DN;
            if (r < I_PLE) { const int kb = r / 32, nb = r % 32; tr_item(a.in[15] + (size_t)l * PLED * DM, DM, 1280, nullptr, (bf16_t*)(wl + WO_PLE), kb * 64, nb * 32, nb * 32, scr, lane); continue; } r -= I_PLE;
            { const int kb = r / 32, nb = r % 32; tr_item(a.in[16] + (size_t)l * DM * DM, DM, 1280, a.in[14] + l * DM, (bf16_t*)(wl + WO_PLE) + 256, kb * 64, nb * 32, nb * 32, scr, lane); }
        }
    }
    {
        LAS float* pws = (LAS float*)(lds + wid * 16384);
        for (int it = gw; it < 2 * 64 * 16; it += NGW) {
            const int nb = it & 15, kb = (it >> 4) & 63, l = it >> 10, g = kb >> 4, k0 = (kb & 15) * 16, n = nb * 64 + lane;
            const float* pwp = a.in[6] + ((size_t)(l * 4 + g) * 256 + k0) * 256;
            LDS_WAIT();
#pragma unroll
            for (int i = 0; i < 16; ++i) *(LAS f32x4*)(pws + (i * 64 + lane) * 4) = *(const f32x4*)(pwp + (i * 64 + lane) * 4);
            LDS_WAIT();
            const float* wy = a.in[5] + (size_t)l * DM * DM + (size_t)(g * 256) * DM + n;
            const float* ps = a.in[7] + l * DM + g * 256;
            float s[16];
#pragma unroll
            for (int kk = 0; kk < 16; ++kk) s[kk] = 0.f;
#pragma unroll 4
            for (int j = 0; j < 256; j += 4) {
                float y[4];
#pragma unroll
                for (int jj = 0; jj < 4; ++jj) y[jj] = wy[(size_t)(j + jj) * DM] * ps[j + jj];
#pragma unroll
                for (int kk = 0; kk < 16; ++kk) { const f32x4 p = *(const LAS f32x4*)(pws + kk * 256 + j); s[kk] += (p[0] * y[0] + p[1] * y[1]) + (p[2] * y[2] + p[3] * y[3]); }
            }
            bf16_t* dst = (bf16_t*)(ws + O_W + (size_t)l * SZ_WL + WO_YA) + (size_t)n * 1536 + 512 + g * 256 + k0;
            u32x4 o0, o1;
            o0.x = cvt_pk_bf16(s[0], s[1]); o0.y = cvt_pk_bf16(s[2], s[3]); o0.z = cvt_pk_bf16(s[4], s[5]); o0.w = cvt_pk_bf16(s[6], s[7]);
            o1.x = cvt_pk_bf16(s[8], s[9]); o1.y = cvt_pk_bf16(s[10], s[11]); o1.z = cvt_pk_bf16(s[12], s[13]); o1.w = cvt_pk_bf16(s[14], s[15]);
            *(u32x4*)dst = o0; *(u32x4*)(dst + 8) = o1;
        }
        LDS_WAIT();
    }
    {
        const float* x = a.in[0]; bf16_t* xb = (bf16_t*)(ws + O_XB0); float* ssa = (float*)(ws + O_SSA);
        for (int row = gw; row < MTOT; row += 4 * NGW) {
            f32x4 v[4][4]; float s[4];
#pragma unroll
            for (int q = 0; q < 4; ++q) { const int r = row + q * NGW; const f32x4* xr = (const f32x4*)(x + (size_t)(r < MTOT ? r : row) * DM) + lane;
#pragma unroll
                for (int j = 0; j < 4; ++j) v[q][j] = xr[64 * j]; }
#pragma unroll
            for (int q = 0; q < 4; ++q) { float t = 0.f;
#pragma unroll
                for (int j = 0; j < 4; ++j) t += (v[q][j][0] * v[q][j][0] + v[q][j][1] * v[q][j][1]) + (v[q][j][2] * v[q][j][2] + v[q][j][3] * v[q][j][3]);
                s[q] = wave_sum(t); }
#pragma unroll
            for (int q = 0; q < 4; ++q) { const int r = row + q * NGW; if (r < MTOT) {
                u32x2* o8 = (u32x2*)(xb + (size_t)r * DM) + lane;
#pragma unroll
                for (int j = 0; j < 4; ++j) { u32x2 w; w.x = cvt_pk_bf16(v[q][j][0], v[q][j][1]); w.y = cvt_pk_bf16(v[q][j][2], v[q][j][3]); o8[64 * j] = w; }
                if (lane < 16) ssa[(size_t)r * 16 + lane] = (lane == 0) ? s[q] : 0.f; } }
        }
    }
    {
        const f32x4* p = (const f32x4*)a.in[1]; u32x4* pb = (u32x4*)(ws + O_PB);
#pragma unroll 4
        for (int id = gt; id < 2 * MTOT * PLED / 8; id += NT) pb[id] = pack8(p[2 * id], p[2 * id + 1]);
    }
    for (int id = gt; id < 2048 * 16; id += NT) {
        const int pos = id >> 4, j = id & 15;
        const double rev = (double)pos * inv_freq(j) * 0.15915494309189535;
        const float fr_ = (float)(rev - __builtin_rint(rev));
        float* rope = (float*)(ws + O_ROPE);
        rope[id] = __builtin_amdgcn_cosf(fr_); rope[32768 + id] = __builtin_amdgcn_sinf(fr_);
    }
}

__device__ __forceinline__ int fK(int row) { return (row & 3) | (((row >> 3) & 3) << 2); }
__device__ __forceinline__ int gV(int row) { return (row & 3) | (((row >> 3) & 1) << 2); }
#define ATT_BAR() do { asm volatile("s_waitcnt lgkmcnt(0)" ::: "memory"); __builtin_amdgcn_s_barrier(); asm volatile("" ::: "memory"); } while (0)
struct AttnItem { size_t own; int g, b, h, r, n; bool has_prev, load_prev; };
__device__ __forceinline__ AttnItem attn_item(int v, int i) {
    AttnItem it; const int job = i >> 2, k = i & 3;
    if (job == 0) { const int sA = v >> 2, seg = v & 3; it.g = 0; it.b = sA >> 2; it.h = sA & 3; it.r = 0; it.n = 4 * seg + k; it.has_prev = it.n > 0; it.load_prev = (k == 0) && (seg > 0); }
    else if (job == 1) { it.g = 1; it.b = v >> 4; it.h = (v >> 2) & 3; it.r = v & 3; it.n = k; it.has_prev = k > 0; it.load_prev = false; }
    else { const int idx = 4 * v + k; it.g = 2; it.b = idx >> 6; it.h = (idx >> 4) & 3; it.r = idx & 15; it.n = 0; it.has_prev = false; it.load_prev = false; }
    const int sh = 2 * it.g;
    it.own = ((size_t)((it.b * 3 + it.g) * 4 + it.h) * 2048 + ((size_t)it.r << (11 - sh)) + (size_t)it.n * 128) * 128;
    return it;
}
__device__ __forceinline__ void attn_phase(LAS unsigned char* lds, const bf16_t* Q, const bf16_t* K, const bf16_t* V, bf16_t* OG, float* LSE, const int tid_in) {
    int tid_ = tid_in; asm volatile("" : "+v"(tid_));
    const int tid = tid_, lane = tid & 63, wid = __builtin_amdgcn_readfirstlane(tid >> 6), fr = lane & 15, fq = lane >> 4;
    const int rt = tid >> 4, ch = tid & 15;
    const int kst = rt * 256 + ((ch ^ fK(rt)) << 4), vst = 65536 + rt * 256 + (((ch >> 1) ^ gV(rt)) << 5) + ((ch & 1) << 4);
    const size_t gsrc = (size_t)rt * 128 + ch * 8;
    const int kb0 = wid < 6 ? wid : 6;
    const int fk = (fr & 3) | (((2 * kb0 + (fr >> 2)) & 3) << 2);
    const int kbase = (16 * kb0 + 8 * (fr >> 2) + (fr & 3)) * 256;
    const int gv = ((fr >> 2) & 3) | ((fq & 1) << 2);
    const int vbase = (16 * kb0 + 8 * fq + (fr >> 2)) * 256 + 8 * (fr & 3);
    { unsigned z0; asm volatile("v_mov_b32 %0, 0" : "=v"(z0));
      const u32x4 zz = {z0, z0, z0, z0};
#pragma unroll
      for (int i = 0; i < 16; ++i) *(LAS u32x4*)(lds + (i * 512 + tid) * 16) = zz; }
    for (int v = blockIdx.x; v < NBC * 16; v += gridDim.x) {
        AttnItem cur = attn_item(v, 0);
        u32x4 kreg[4], vreg[4]; bf16x8 qn[4];
#pragma unroll
        for (int i = 0; i < 4; ++i) { kreg[i] = *(const u32x4*)(K + cur.own + gsrc + (size_t)i * 4096); vreg[i] = *(const u32x4*)(V + cur.own + gsrc + (size_t)i * 4096); }
#pragma unroll
        for (int ks = 0; ks < 4; ++ks) qn[ks] = *(const bf16x8*)(Q + cur.own + (size_t)(wid * 16 + fr) * 128 + 8 * fq + 32 * ks);
        for (int it = 0; it < 12; ++it) {
            const int tog = it & 1, tx = (tog ^ 1) << 15;
            ATT_BAR();
#pragma unroll
            for (int i = 0; i < 4; ++i) { *(LAS u32x4*)(lds + tog * 32768 + kst + i * 8192) = kreg[i]; *(LAS u32x4*)(lds + tog * 32768 + vst + i * 8192) = vreg[i]; }
            bf16x8 qf[4];
#pragma unroll
            for (int ks = 0; ks < 4; ++ks) qf[ks] = qn[ks];
            if (cur.load_prev) {
#pragma unroll
                for (int i = 0; i < 4; ++i) { kreg[i] = *(const u32x4*)(K + cur.own - 16384 + gsrc + (size_t)i * 4096); vreg[i] = *(const u32x4*)(V + cur.own - 16384 + gsrc + (size_t)i * 4096); }
#pragma unroll
                for (int i = 0; i < 4; ++i) { *(LAS u32x4*)(lds + (tog ^ 1) * 32768 + kst + i * 8192) = kreg[i]; *(LAS u32x4*)(lds + (tog ^ 1) * 32768 + vst + i * 8192) = vreg[i]; }
            }
            const AttnItem me = cur;
            if (it + 1 < 12) {
                cur = attn_item(v, it + 1);
#pragma unroll
                for (int i = 0; i < 4; ++i) { kreg[i] = *(const u32x4*)(K + cur.own + gsrc + (size_t)i * 4096); vreg[i] = *(const u32x4*)(V + cur.own + gsrc + (size_t)i * 4096); }
#pragma unroll
                for (int ks = 0; ks < 4; ++ks) qn[ks] = *(const bf16x8*)(Q + cur.own + (size_t)(wid * 16 + fr) * 128 + 8 * fq + 32 * ks);
            }
            ATT_BAR();
            f32x4 SA[5], SB[5];
#pragma unroll
            for (int gp = 0; gp < 5; ++gp) { SA[gp] = (f32x4){0.f, 0.f, 0.f, 0.f}; SB[gp] = SA[gp]; }
            int agp[5], bgp[5];
#pragma unroll
            for (int gp = 0; gp < 5; ++gp) { agp[gp] = (kbase + gp * 8192) ^ tx; bgp[gp] = 65536 + ((vbase + gp * 8192) ^ tx); asm volatile("" : "+v"(agp[gp]), "+v"(bgp[gp])); }
            bf16x8 fa[2][10];
            { int kc = ((fq + 0) ^ fk) << 4; asm volatile("" : "+v"(kc));
#pragma unroll
              for (int gp = 0; gp < 5; ++gp) { const LAS unsigned char* pa = lds + (agp[gp] + kc); fa[0][2 * gp] = *(const LAS bf16x8*)(pa); fa[0][2 * gp + 1] = *(const LAS bf16x8*)(pa + 1024); } }
#pragma unroll
            for (int ks = 0; ks < 4; ++ks) {
                if (ks < 3) { int kc = ((fq + 4 * (ks + 1)) ^ fk) << 4; asm volatile("" : "+v"(kc));
#pragma unroll
                    for (int gp = 0; gp < 5; ++gp) { const LAS unsigned char* pa = lds + (agp[gp] + kc); fa[(ks + 1) & 1][2 * gp] = *(const LAS bf16x8*)(pa); fa[(ks + 1) & 1][2 * gp + 1] = *(const LAS bf16x8*)(pa + 1024); } }
                __builtin_amdgcn_sched_barrier(0);
#pragma unroll
                for (int gp = 0; gp < 5; ++gp) {
                    SA[gp] = __builtin_amdgcn_mfma_f32_16x16x32_bf16(fa[ks & 1][2 * gp], qf[ks], SA[gp], 0, 0, 0);
                    SB[gp] = __builtin_amdgcn_mfma_f32_16x16x32_bf16(fa[ks & 1][2 * gp + 1], qf[ks], SB[gp], 0, 0, 0);
                }
                __builtin_amdgcn_sched_barrier(0);
            }
            const int qi = 16 * wid + fr; const int kmin = me.has_prev ? qi : (qi > 128 ? qi : 128);
            float mx = -INFINITY;
#pragma unroll
            for (int gp = 0; gp < 5; ++gp)
#pragma unroll
                for (int j = 0; j < 4; ++j) {
                    const int kkA = 16 * kb0 + 32 * gp + 8 * fq + j, kkB = kkA + 4;
                    if (!(kkA >= kmin && kkA <= qi + 128)) SA[gp][j] = -INFINITY;
                    if (!(kkB >= kmin && kkB <= qi + 128)) SB[gp][j] = -INFINITY;
                    mx = fmaxf(mx, fmaxf(SA[gp][j], SB[gp][j]));
                }
            mx = xmax16(mx); mx = xmax32(mx);
            float l = 0.f; bf16x8 bP[5];
#pragma unroll
            for (int gp = 0; gp < 5; ++gp) {
                f32x4 pa, pb;
#pragma unroll
                for (int j = 0; j < 4; ++j) { pa[j] = __builtin_amdgcn_exp2f(SA[gp][j] - mx); pb[j] = __builtin_amdgcn_exp2f(SB[gp][j] - mx); l += pa[j] + pb[j]; }
                const u32x4 w = pack8(pa, pb); bP[gp] = __builtin_bit_cast(bf16x8, w);
            }
            l = xsum16(l); l = xsum32(l);
            const float inv_l = __builtin_amdgcn_rcpf(l);
            const int sh = 2 * me.g;
            const int tok = ((me.n * 128 + qi) << sh) + me.r;
            const size_t orow = (size_t)me.g * MC + (size_t)me.b * 2048 + tok;
            v4i16_t fv[2][10];
            { int vc = (0 ^ gv) << 5; asm volatile("" : "+v"(vc));
#pragma unroll
              for (int gp = 0; gp < 5; ++gp) { const LAS unsigned char* pv = lds + (bgp[gp] + vc); fv[0][2 * gp] = __builtin_amdgcn_ds_read_tr16_b64_v4i16((LAS v4i16_t*)(pv)); fv[0][2 * gp + 1] = __builtin_amdgcn_ds_read_tr16_b64_v4i16((LAS v4i16_t*)(pv + 1024)); } }
            bf16_t* op16 = OG + orow * 512 + me.h * 128 + 16 * (fq & 1) + 8 * (fq >> 1);
            u32x2 wprev = {0u, 0u};
#pragma unroll
            for (int d0 = 0; d0 < 8; ++d0) {
                if (d0 < 7) { int vc = ((d0 + 1) ^ gv) << 5; asm volatile("" : "+v"(vc));
#pragma unroll
                    for (int gp = 0; gp < 5; ++gp) { const LAS unsigned char* pv = lds + (bgp[gp] + vc); fv[(d0 + 1) & 1][2 * gp] = __builtin_amdgcn_ds_read_tr16_b64_v4i16((LAS v4i16_t*)(pv)); fv[(d0 + 1) & 1][2 * gp + 1] = __builtin_amdgcn_ds_read_tr16_b64_v4i16((LAS v4i16_t*)(pv + 1024)); } }
                __builtin_amdgcn_sched_barrier(0);
                f32x4 o = {0.f, 0.f, 0.f, 0.f};
#pragma unroll
                for (int gp = 0; gp < 5; ++gp) {
                    const v4i16_t lo = fv[d0 & 1][2 * gp], hi = fv[d0 & 1][2 * gp + 1];
                    const bf16x8 av = {lo[0], lo[1], lo[2], lo[3], hi[0], hi[1], hi[2], hi[3]};
                    o = __builtin_amdgcn_mfma_f32_16x16x32_bf16(av, bP[gp], o, 0, 0, 0);
                }
                u32x2 w; w.x = cvt_pk_bf16(o[0] * inv_l, o[1] * inv_l); w.y = cvt_pk_bf16(o[2] * inv_l, o[3] * inv_l);
                if (d0 & 1) {
                    const auto sx = __builtin_amdgcn_permlane16_swap(wprev.x, w.x, false, false);
                    const auto sy = __builtin_amdgcn_permlane16_swap(wprev.y, w.y, false, false);
                    u32x4 st; st.x = sx[0]; st.y = sy[0]; st.z = sx[1]; st.w = sy[1];
                    *(u32x4*)(op16 + 16 * (d0 - 1)) = st;
                } else wprev = w;
                __builtin_amdgcn_sched_barrier(0);
            }
            if (fq == 0) LSE[orow * 4 + me.h] = mx + __builtin_amdgcn_logf(l);
        }
    }
    __syncthreads();
}
__device__ __forceinline__ void pool_phase(const bf16_t* UP, bf16_t* POOLED, const int tid_in) {
    int tid_ = tid_in; asm volatile("" : "+v"(tid_));
    const int gt = blockIdx.x * NTHREADS + tid_, NT = gridDim.x * NTHREADS;
    constexpr int PR = 32;
    for (int id = gt; id < (MC / PR) * 128; id += NT) {
        const int seg = id >> 7, ch = id & 127, g = ch >> 5, w = 2 << g, row0 = seg * PR, t0 = row0 & 2047;
        const bf16_t* src = UP + (size_t)row0 * 1024 + ch * 8;
        bf16_t* dst = POOLED + (size_t)row0 * 1536 + 512 + ch * 8;
        f32x4 s0 = {0.f, 0.f, 0.f, 0.f}, s1 = s0;
        const int pre = (t0 < w - 1) ? t0 : (w - 1);
        for (int j = 1; j <= pre; ++j) { f32x4 a0, a1; unpack8(*(const u32x4*)(src - (size_t)j * 1024), a0, a1); s0 += a0; s1 += a1; }
#pragma unroll 4
        for (int i = 0; i < PR; ++i) {
            f32x4 u0, u1; unpack8(*(const u32x4*)(src + (size_t)i * 1024), u0, u1);
            s0 += u0; s1 += u1;
            const int t = t0 + i, cnt = (t + 1 < w) ? t + 1 : w;
            const float ic = 1.f / (float)cnt;
            *(u32x4*)(dst + (size_t)i * 1536) = pack8(s0 * ic - u0, s1 * ic - u1);
            if (t >= w - 1) { f32x4 o0, o1; unpack8(*(const u32x4*)(src + (size_t)(i - (w - 1)) * 1024), o0, o1); s0 -= o0; s1 -= o1; }
        }
    }
}
__device__ __forceinline__ void merge_phase(const bf16_t* OG, const float* LSE, bf16_t* ATTN, const int tid_in) {
    int tid_ = tid_in; asm volatile("" : "+v"(tid_));
    const int gt = blockIdx.x * NTHREADS + tid_, NT = gridDim.x * NTHREADS;
    for (int id = gt; id < MC * 64; id += NT) {
        const int row = id >> 6, ch = id & 63, h = ch >> 4;
        const float l0 = LSE[(size_t)row * 4 + h], l1 = LSE[((size_t)MC + row) * 4 + h], l2 = LSE[((size_t)2 * MC + row) * 4 + h];
        const float mx = fmaxf(l0, fmaxf(l1, l2));
        float w0 = __builtin_amdgcn_exp2f(l0 - mx), w1 = __builtin_amdgcn_exp2f(l1 - mx), w2 = __builtin_amdgcn_exp2f(l2 - mx);
        const float inv = 1.f / (w0 + w1 + w2); w0 *= inv; w1 *= inv; w2 *= inv;
        f32x4 a0, a1, b0, b1, c0, c1;
        unpack8(*(const u32x4*)(OG + (size_t)row * 512 + ch * 8), a0, a1);
        unpack8(*(const u32x4*)(OG + ((size_t)MC + row) * 512 + ch * 8), b0, b1);
        unpack8(*(const u32x4*)(OG + ((size_t)2 * MC + row) * 512 + ch * 8), c0, c1);
        *(u32x4*)(ATTN + (size_t)row * 1536 + ch * 8) = pack8(a0 * w0 + b0 * w1 + c0 * w2, a1 * w0 + b1 * w1 + c1 * w2);
    }
}
__device__ __forceinline__ void fixup_phase(const float* hb, const float* cw, const float* cb, bf16_t* act, const int tid_in) {
    int tid_ = tid_in; asm volatile("" : "+v"(tid_));
    const int gt = blockIdx.x * NTHREADS + tid_, NT = gridDim.x * NTHREADS;
    for (int id = gt; id < (MC / 64) * DFF; id += NT) {
        const int blk = id / DFF, j = id - blk * DFF, row0 = blk * 64;
        const bool first = (row0 & 2047) == 0;
        const float* h0 = hb + (size_t)blk * 4 * (2 * DFF) + j;
        const float* hp = h0 - (size_t)4 * (2 * DFF);
        const float u0g = h0[0], u0v = h0[DFF], u1g = h0[2 * DFF], u1v = h0[3 * DFF];
        float m1g = 0.f, m1v = 0.f, m2g = 0.f, m2v = 0.f;
        if (!first) { m2g = hp[2 * (2 * DFF)]; m2v = hp[2 * (2 * DFF) + DFF]; m1g = hp[3 * (2 * DFF)]; m1v = hp[3 * (2 * DFF) + DFF]; }
        const float w0g = cw[j], w1g = cw[2 * DFF + j], w2g = cw[4 * DFF + j], bg = cb[j];
        const float w0v = cw[DFF + j], w1v = cw[3 * DFF + j], w2v = cw[5 * DFF + j], bv = cb[DFF + j];
        const float y0g = bg + w2g * u0g + w1g * m1g + w0g * m2g, y0v = bv + w2v * u0v + w1v * m1v + w0v * m2v;
        const float y1g = bg + w2g * u1g + w1g * u0g + w0g * m1g, y1v = bv + w2v * u1v + w1v * u0v + w0v * m1v;
        act[(size_t)row0 * DFF + j] = (bf16_t)(cvt_pk_bf16(silu_mul(y0g, y0v), 0.f) & 0xffffu);
        act[(size_t)(row0 + 1) * DFF + j] = (bf16_t)(cvt_pk_bf16(silu_mul(y1g, y1v), 0.f) & 0xffffu);
    }
}
__device__ __forceinline__ void final_phase(float* out, const bf16_t* xb, const float* ssa, const float* gf, const int tid_in) {
    int tid_ = tid_in; asm volatile("" : "+v"(tid_));
    const int lane = tid_ & 63, gw = blockIdx.x * 8 + (tid_ >> 6), NGW = gridDim.x * 8;
    for (int row = gw; row < MTOT; row += NGW) {
        const float rs = rowscale(ssa, row);
        const u32x4* xr = (const u32x4*)(xb + (size_t)row * DM) + lane; f32x4* orow = (f32x4*)(out + (size_t)row * DM) + 2 * lane; const f32x4* gr = (const f32x4*)gf + 2 * lane;
#pragma unroll
        for (int j = 0; j < 2; ++j) { f32x4 v0, v1; unpack8(xr[64 * j], v0, v1); orow[128 * j] = v0 * rs * gr[128 * j]; orow[128 * j + 1] = v1 * rs * gr[128 * j + 1]; }
    }
}

#define XB_TMO      128
#define XB_XCNT(j)  (256  + 64 * (j))
#define XB_XSUB(j)  (1280 + 64 * (j))
#define XB_XGEN(j)  (2304 + 64 * (j))
#define XB_TOP      3328
#define XB_TOPGEN   3392
#define XCD_BAR_WORDS 3456
#define XB_SPIN_CAP (1u << 18)

__device__ __forceinline__ unsigned xb_ld(unsigned* p)              { return __hip_atomic_load(p, __ATOMIC_RELAXED, __HIP_MEMORY_SCOPE_AGENT); }
__device__ __forceinline__ unsigned xb_add(unsigned* p, unsigned v) { return __hip_atomic_fetch_add(p, v, __ATOMIC_RELAXED, __HIP_MEMORY_SCOPE_AGENT); }
__device__ __forceinline__ unsigned xb_xcc_id() { return (unsigned)__builtin_amdgcn_s_getreg((3 << 11) | 20) & 0xFu; }
#define XB_SPIN(cond, bar) do { unsigned _sp = 0; while (cond) { __builtin_amdgcn_s_sleep(1); \
    if ((++_sp & 255u) == 0u) { if (xb_ld(&(bar)[XB_TMO])) break; if (_sp > XB_SPIN_CAP) { atomicAdd(&(bar)[XB_TMO], 1u); break; } } } } while (0)

struct XcdBarrier {
    unsigned* bar; unsigned x;
    volatile LAS unsigned* st;
};

__device__ __forceinline__ XcdBarrier xcd_barrier_post(unsigned* bar, volatile LAS unsigned* st) {
    XcdBarrier b; b.bar = bar; b.x = xb_xcc_id(); b.st = st;
    if (threadIdx.x == 0) (void)xb_add(&bar[XB_XCNT(b.x)], 1u);
    return b;
}
__device__ __forceinline__ void xcd_barrier_complete(unsigned* bar, unsigned x, unsigned& nloc, unsigned& nx) {
    const unsigned G = gridDim.x * gridDim.y * gridDim.z;
    unsigned sum, cnt, mine, sp = 0u;
    for (;;) {
        sum = 0u; cnt = 0u; mine = 0u;
#pragma unroll
        for (unsigned j = 0; j < 16; ++j) { const unsigned c = xb_ld(&bar[XB_XCNT(j)]); sum += c; cnt += (c > 0u) ? 1u : 0u; mine = (j == x) ? c : mine; }
        if (sum == G) break;
        __builtin_amdgcn_s_sleep(1);
        if ((++sp & 255u) == 0u) { if (xb_ld(&bar[XB_TMO])) break; if (sp > XB_SPIN_CAP) { atomicAdd(&bar[XB_TMO], 1u); break; } }
    }
    nloc = mine > 0u ? mine : 1u; nx = cnt > 0u ? cnt : 1u;
}

__device__ __forceinline__ void xcd_barrier(const XcdBarrier& b) {
    asm volatile("s_waitcnt vmcnt(0)" ::: "memory");
    __syncthreads();
    if (threadIdx.x == 0) {
        unsigned* bar = b.bar;
        __builtin_amdgcn_s_waitcnt(0);
        unsigned nloc = b.st[0], nx = b.st[1];
        if (nloc == 0u) { xcd_barrier_complete(bar, b.x, nloc, nx); b.st[0] = nloc; b.st[1] = nx; }
        const unsigned old = xb_add(&bar[XB_XSUB(b.x)], 1u);
        const unsigned gen = old / nloc;
        if (old + 1u == (gen + 1u) * nloc) {
            __builtin_amdgcn_fence(__ATOMIC_RELEASE, "agent");
            asm volatile("s_waitcnt vmcnt(0)" ::: "memory");
            const unsigned og = xb_add(&bar[XB_TOP], 1u);
            const unsigned tg = og / nx;
            if (og + 1u == (tg + 1u) * nx) xb_add(&bar[XB_TOPGEN], 1u);
            else XB_SPIN(xb_ld(&bar[XB_TOPGEN]) == tg, bar);
            __builtin_amdgcn_fence(__ATOMIC_ACQUIRE, "agent");
            xb_add(&bar[XB_XGEN(b.x)], 1u);
            asm volatile("s_waitcnt vmcnt(0)" ::: "memory");
        } else {
            XB_SPIN(xb_ld(&bar[XB_XGEN(b.x)]) == gen, bar);
            __builtin_amdgcn_fence(__ATOMIC_ACQUIRE, "agent");
            asm volatile("s_waitcnt vmcnt(0)" ::: "memory");
        }
    }
    __syncthreads();
}

#ifndef MK_MASK
#define MK_MASK 0xffff
#endif
#ifndef MK_DUP
#define MK_DUP 0
#endif
#ifndef MK_DUPATT
#define MK_DUPATT 0
#endif
#ifndef MK_XBAR
#define MK_XBAR 0
#endif
#ifndef MK_STAGGER
#define MK_STAGGER 0
#endif
#ifndef MK_DUPNULL
#define MK_DUPNULL 0
#endif
constexpr int NSUB = 9, NSTEPS = 1 + NCH * DEPTH * NSUB + 1;
#ifndef MK_WGM_Z
#define MK_WGM_Z 4
#endif
#ifndef MK_WGM_UP
#define MK_WGM_UP 8
#endif
#ifndef MK_WGM_S
#define MK_WGM_S 4
#endif
__device__ __forceinline__ void fill_rs(LAS float* tab, const float* part, int M, int N, int GX, int BX, int tid_in) {
    int tid = tid_in; asm volatile("" : "+v"(tid));
    pg8::StaticOrder S; S.init(M, N, GX, BX, N == INW ? MK_WGM_Z : (N == 2 * DFF ? MK_WGM_UP : MK_WGM_S));
    int nu = 0; { pg8::Unit u; while (nu < RS_UNITS && S.next(nu, u)) ++nu; }
#pragma unroll
    for (int j = 0; j < RS_UNITS / 2; ++j) { const int i = 2 * j + (tid >> 8); if (i < nu) { pg8::Unit u; S.next(i, u); tab[i * 256 + (tid & 255)] = rowscale(part, u.pm * 256 + (tid & 255)); } }
    __syncthreads();
}
#define GEMM_CALL(EPI, g, E) do { pg8::StaticOrder S_; S_.init((g).M, (g).N, GX, BX, (g).N == INW ? MK_WGM_Z : ((g).N == 2 * DFF ? MK_WGM_UP : MK_WGM_S)); pg8::gemm_phase<EPI, pg8::StaticOrder, true, true>(lds, g, S_, E, tidv); } while (0)
__device__ __forceinline__ int make_tid(int wid0) { int l; asm volatile("v_mbcnt_lo_u32_b32 %0, -1, 0\n\tv_mbcnt_hi_u32_b32 %0, -1, %0" : "=v"(l)); return wid0 * 64 + l; }
__device__ __forceinline__ void run_step(LAS unsigned char* lds, int step, const int wid0) {
    const __attribute__((address_space(4))) Args* ap = (const __attribute__((address_space(4))) Args*)__builtin_amdgcn_kernarg_segment_ptr();
    long zero = 0; asm volatile("" : "+s"(zero), "+s"(ap));
    Args a;
#pragma unroll
    for (int i = 0; i < 18; ++i) a.in[i] = ap->in[i];
    a.out = ap->out; a.ws = ap->ws; a.lo = 0; a.hi = 0;
    const int wid0z = wid0 + (int)zero;
#define tidv make_tid(wid0z)
    const int GX = (int)gridDim.x + (int)zero, BX = (int)blockIdx.x + (int)zero;
    unsigned char* ws = a.ws;
    if (step == NSTEPS - 1) { if (MK_MASK & 1024) final_phase(a.out, (const bf16_t*)(ws + O_XB0), (const float*)(ws + O_SSA), a.in[17], tidv); return; }
    const int s0 = step - 1, c = s0 / (DEPTH * NSUB), l = (s0 / NSUB) % DEPTH, sub = s0 % NSUB;
    const size_t r0 = (size_t)c * MC;
    unsigned char* wl = ws + O_W + (size_t)l * SZ_WL;
    bf16_t* xb0 = (bf16_t*)(ws + O_XB0) + r0 * DM; bf16_t* xb1 = (bf16_t*)(ws + O_XB1); bf16_t* xb2 = (bf16_t*)(ws + O_XB2);
    float* ssa = (float*)(ws + O_SSA) + r0 * 16; float* ssb = (float*)(ws + O_SSB) + r0 * 16; float* ssc = (float*)(ws + O_SSC) + r0 * 16;
    if (sub == 0 && (MK_MASK & 1)) {
        pg8::Gemm g{xb0, (const bf16_t*)(wl + WO_IN), MC, INW, DM};
        fill_rs((LAS float*)(lds + LDS_RS), ssa, MC, INW, GX, BX, tidv);
#if MK_STAGGER
        if ((BX >> 3) & 1) { for (int i = 0; i < MK_STAGGER; ++i) __builtin_amdgcn_s_sleep(127); }
#endif
        EpiZ E{ssa, (const float*)(ws + O_ROPE), (bf16_t*)(ws + O_Q), (bf16_t*)(ws + O_UP), (const LAS float*)(lds + LDS_RS)};
        GEMM_CALL(EpiZ, g, E);
#if MK_DUPNULL & 1
        { EpiNull EN{(float*)(ws + O_BAR + 65536)}; GEMM_CALL(EpiNull, g, EN); }
#endif
    } else if (sub == 1 && (MK_MASK & 2)) {
        attn_phase(lds, (const bf16_t*)(ws + O_Q), (const bf16_t*)(ws + O_Q) + (size_t)MC * 1536, (const bf16_t*)(ws + O_Q) + (size_t)2 * MC * 1536, (bf16_t*)(ws + O_OG), (float*)(ws + O_LSE), tidv);
#if MK_DUPATT
        attn_phase(lds, (const bf16_t*)(ws + O_Q), (const bf16_t*)(ws + O_Q) + (size_t)MC * 1536, (const bf16_t*)(ws + O_Q) + (size_t)2 * MC * 1536, (bf16_t*)(ws + O_OG), (float*)(ws + O_LSE), tidv);
#endif
        pool_phase((const bf16_t*)(ws + O_UP), (bf16_t*)(ws + O_ATTN), tidv);
    } else if (sub == 2 && (MK_MASK & 4)) {
        merge_phase((const bf16_t*)(ws + O_OG), (const float*)(ws + O_LSE), (bf16_t*)(ws + O_ATTN), tidv);
    } else if (sub == 3 && (MK_MASK & 8)) {
        pg8::Gemm g{(const bf16_t*)(ws + O_ATTN), (const bf16_t*)(wl + WO_YA), MC, DM, 1536};
        EpiAB E{(const bf16_t*)(ws + O_UP) + (size_t)MC * 1024, (const bf16_t*)(ws + O_UP) + (size_t)2 * MC * 1024, (bf16_t*)(ws + O_MERGED)};
        GEMM_CALL(EpiAB, g, E);
    } else if (sub == 4 && (MK_MASK & 16)) {
        pg8::Gemm g{(const bf16_t*)(ws + O_MERGED), (const bf16_t*)(wl + WO_O), MC, DM, DM};
        EpiRes<0> E{xb0, xb1, ssb, nullptr, nullptr, nullptr, 1024, 1024};
        GEMM_CALL(EpiRes<0>, g, E);
    } else if (sub == 5 && (MK_MASK & 32)) {
        pg8::Gemm g{xb1, (const bf16_t*)(wl + WO_UP), MC, 2 * DFF, DM};
        fill_rs((LAS float*)(lds + LDS_RS), ssb, MC, 2 * DFF, GX, BX, tidv);
        EpiConv E{ssb, a.in[11] + (size_t)l * 3 * 2 * DFF, a.in[12] + (size_t)l * 2 * DFF, (bf16_t*)(ws + O_ACT), (float*)(ws + O_HB), (const LAS float*)(lds + LDS_RS), (LAS float*)(lds + LDS_CW)};
        GEMM_CALL(EpiConv, g, E);
#if MK_DUPNULL & 2
        { EpiNull EN{(float*)(ws + O_BAR + 65536)}; GEMM_CALL(EpiNull, g, EN); }
#endif
    } else if (sub == 6 && (MK_MASK & 64)) {
        fixup_phase((const float*)(ws + O_HB), a.in[11] + (size_t)l * 3 * 2 * DFF, a.in[12] + (size_t)l * 2 * DFF, (bf16_t*)(ws + O_ACT), tidv);
        {
          int tid_ = tidv; asm volatile("" : "+v"(tid_));
          const u32x4* src = (const u32x4*)((const bf16_t*)(ws + O_PB) + ((size_t)l * MTOT + r0) * PLED);
          for (int id = blockIdx.x * NTHREADS + tid_; id < MC * 32; id += gridDim.x * NTHREADS) *(u32x4*)(xb2 + (size_t)(id >> 5) * 1280 + (id & 31) * 8) = src[id]; }
    } else if (sub == 7 && (MK_MASK & 128)) {
        { pg8::Gemm g{(const bf16_t*)(ws + O_ACT), (const bf16_t*)(wl + WO_DN), MC, DM, DFF};
          EpiRes<0> E{xb1, xb2 + 256, ssc, nullptr, nullptr, nullptr, 1024, 1280};
          GEMM_CALL(EpiRes<0>, g, E); }
    } else if (MK_MASK & 256) {
        pg8::Gemm g{xb2, (const bf16_t*)(wl + WO_PLE), MC, DM, 1280};
        fill_rs((LAS float*)(lds + LDS_RS), ssc, MC, DM, GX, BX, tidv);
        EpiRes<1> E{xb2 + 256, xb0, ssa, (bf16_t*)(ws + O_PW), ssc, (const LAS float*)(lds + LDS_RS), 1280, 1024};
        GEMM_CALL(EpiRes<1>, g, E);
    }
}

#undef tidv
template <bool COOP>
__global__ void __launch_bounds__(NTHREADS, 2) fwd(Args a) {
    extern __shared__ __attribute__((aligned(16))) unsigned char lds_raw[];
    LAS unsigned char* lds = (LAS unsigned char*)lds_raw;
    const int wid0 = __builtin_amdgcn_readfirstlane((int)threadIdx.x >> 6);
    XcdBarrier bar; bar.bar = nullptr; bar.x = 0; bar.st = nullptr;
    if constexpr (COOP) {
        volatile LAS unsigned* st = (volatile LAS unsigned*)(lds + 131072);
        if (threadIdx.x < 2) st[threadIdx.x] = 0u;
        __syncthreads();
        bar = xcd_barrier_post((unsigned*)(a.ws + O_BAR), st);
    }
    int s = a.lo;
    if (s == 0 && s < a.hi) { if (MK_MASK & 512) prologue(a, lds, make_tid(wid0));
#if MK_DUP & 512
        prologue(a, lds, make_tid(wid0));
#endif
 ++s; if constexpr (COOP) { if (s < a.hi) cg::this_grid().sync(); } }
    for (; s < a.hi; ++s) {
        run_step(lds, s, wid0);
#if MK_DUP
        if (s < NSTEPS - 1 && ((MK_DUP >> ((s - 1) % NSUB)) & 1)) run_step(lds, s, wid0);
#endif
        if constexpr (COOP) { if (s + 1 < a.hi) xcd_barrier(bar); }
#if MK_XBAR
        if constexpr (COOP) { if (s + 1 < a.hi) xcd_barrier(bar); }
#endif
    }
}

extern "C" void kernel_launch(void* const* d_in, const int* in_sizes, int n_in, void* d_out, int out_size, void* d_ws, size_t ws_size, hipStream_t stream) {
    static int grid = 0;
    if (grid == 0) {
        if (n_in != 18 || in_sizes[0] != MTOT * DM || out_size != MTOT * DM || ws_size < O_END) {
            fprintf(stderr, "kernel_launch: unexpected shapes or workspace (n_in %d, in0 %d, out %d, ws %zu, need %zu); nothing launched\n", n_in, n_in > 0 ? in_sizes[0] : -1, out_size, ws_size, (size_t)O_END);
            grid = -1; return; }
        int dev = 0, cus = 0, per_cu = 0;
        if (hipGetDevice(&dev) != hipSuccess || hipDeviceGetAttribute(&cus, hipDeviceAttributeMultiprocessorCount, dev) != hipSuccess) { grid = -1; return; }
#if MK_SINGLE
#define FWD_K fwd<true>
#else
#define FWD_K fwd<false>
#endif
        if (hipFuncSetAttribute((const void*)FWD_K, hipFuncAttributeMaxDynamicSharedMemorySize, LDS_BYTES) != hipSuccess) { fprintf(stderr, "kernel_launch: hipFuncSetAttribute failed\n"); grid = -1; return; }
        if (hipOccupancyMaxActiveBlocksPerMultiprocessor(&per_cu, (const void*)FWD_K, NTHREADS, LDS_BYTES) != hipSuccess || per_cu < 1) { fprintf(stderr, "kernel_launch: occupancy query says %d blocks per CU\n", per_cu); per_cu = 1; }
        (void)hipGetLastError();
        grid = cus * per_cu;
    }
    if (grid < 0) return;
    if (hipMemsetAsync((char*)d_ws + O_BAR, 0, XCD_BAR_WORDS * 4, stream) != hipSuccess) { fprintf(stderr, "kernel_launch: memset of the barrier words failed\n"); return; }
    Args a{};
    for (int i = 0; i < 18; ++i) a.in[i] = (const float*)d_in[i];
    a.out = (float*)d_out; a.ws = (unsigned char*)d_ws;
#if MK_SINGLE
    a.lo = 0; a.hi = NSTEPS;
    void* args[] = {&a};
    const hipError_t e = hipLaunchCooperativeKernel((const void*)fwd<true>, dim3(grid), dim3(NTHREADS), args, LDS_BYTES, stream);
    if (e != hipSuccess) fprintf(stderr, "kernel_launch: cooperative launch failed: %s (grid %d)\n", hipGetErrorString(e), grid);
#else
    for (int s = 0; s < NSTEPS; ++s) { a.lo = s; a.hi = s + 1; hipLaunchKernelGGL(fwd<false>, dim3(grid), dim3(NTHREADS), LDS_BYTES, stream, a); }
#endif
}
```
